# Optimizing an MI355X kernel written in HIP

```python
import math
import jax, jax.numpy as jnp
from jax import lax
import numpy as np

D_MODEL = 1024
BATCH = 16
SEQ = 2048
DEPTH = 4

CTX_LEN = 256
GRID_W = 64

N_HEADS = 8
HEAD_DIM = 64
V_DIM = 2 * HEAD_DIM
QK_W = N_HEADS * 2 * HEAD_DIM
ATTN_W = N_HEADS * V_DIM
CONV_W = D_MODEL
CONV_K = 3
N_FGROUPS = 8
FGROUP_DIM = 128
FOURIER_W = N_FGROUPS * FGROUP_DIM
N_BRANCH = 3
ROPE_BASE = 10000.0
AXIS_DIM = HEAD_DIM // 2
Q_BLOCK = 128
NORM_EPS = 1e-6
SUBLN_EPS = 1e-5

SPLIT_SIZES = (QK_W, QK_W, ATTN_W, ATTN_W,
               CONV_W, CONV_W, CONV_W, CONV_W,
               FOURIER_W, FOURIER_W,
               N_BRANCH * D_MODEL)
PROJ_W = 2 * QK_W + 2 * ATTN_W + 4 * CONV_W + 2 * FOURIER_W + N_BRANCH * D_MODEL

kernel_name = "hybrid_diffattn_shortconv_fourier_dit"


def rmsnorm(x, w, eps=NORM_EPS):
    xf = x.astype(jnp.float32)
    y = xf * lax.rsqrt(jnp.mean(xf * xf, axis=-1, keepdims=True) + eps)
    return y.astype(x.dtype) * w


def adaln(cond, w_mod, b_mod):
    mod = jax.nn.silu(cond) @ w_mod + b_mod
    shift, scale, gate = jnp.split(mod, 3, axis=-1)
    return (jnp.expand_dims(shift, -2), jnp.expand_dims(scale, -2), jnp.expand_dims(gate, -2))


def split_proj(p):
    idx = [int(i) for i in np.cumsum(SPLIT_SIZES)[:-1]]
    return jnp.split(p, idx, axis=-1)


def axial_angles(n_tokens):
    rows = n_tokens // GRID_W
    row = jnp.repeat(jnp.arange(rows), GRID_W).astype(jnp.float32)
    col = jnp.tile(jnp.arange(GRID_W), rows).astype(jnp.float32)
    inv_freq = ROPE_BASE ** (-jnp.arange(0, AXIS_DIM, 2, dtype=jnp.float32) / AXIS_DIM)
    return row[:, None] * inv_freq, col[:, None] * inv_freq


def rotate(x, ang):
    cos = jnp.cos(ang).astype(x.dtype)
    sin = jnp.sin(ang).astype(x.dtype)
    x1, x2 = jnp.split(x, 2, axis=-1)
    return jnp.concatenate([x1 * cos - x2 * sin, x2 * cos + x1 * sin], axis=-1)


def axial_rope(x, ang_r, ang_c):
    xr, xc = jnp.split(x, 2, axis=-1)
    return jnp.concatenate([rotate(xr, ang_r), rotate(xc, ang_c)], axis=-1)


def qk_heads(t):
    b, n, _ = t.shape
    return t.reshape(b, n, N_HEADS, 2, HEAD_DIM).transpose(0, 2, 3, 1, 4)


def v_heads(t):
    b, n, _ = t.shape
    return t.reshape(b, n, N_HEADS, V_DIM).transpose(0, 2, 1, 3)


def diff_weights(q, k, lam):
    s = jnp.einsum('bhmqd,bhmkd->bhmqk', q, k).astype(jnp.float32) / math.sqrt(HEAD_DIM)
    p = jax.nn.softmax(s, axis=-1)
    return p[:, :, 0] - lam * p[:, :, 1]


def latent_diff_attn(q, k, v, lam):
    b, h, _, s, d = q.shape
    nblk = s // Q_BLOCK
    qb = jnp.moveaxis(q.reshape(b, h, 2, nblk, Q_BLOCK, d), 3, 0)

    def one_block(qblk):
        a = diff_weights(qblk, k, lam).astype(v.dtype)
        return jnp.einsum('bhqk,bhkv->bhqv', a, v)

    o = lax.map(one_block, qb)
    return jnp.moveaxis(o, 0, 2).reshape(b, h, s, V_DIM)


def context_diff_attn(q, k, v, lam):
    a = diff_weights(q, k, lam).astype(v.dtype)
    return jnp.einsum('bhqk,bhkv->bhqv', a, v)


def subln(o, w, lam_init):
    b, h, n, vd = o.shape
    y = rmsnorm(o, w, SUBLN_EPS) * (1.0 - lam_init)
    return y.transpose(0, 2, 1, 3).reshape(b, n, h * vd)


def short_conv(xin, b_g, c_g, conv_w):
    u = c_g * xin
    up = jnp.pad(u, ((0, 0), (1, 1), (0, 0)))
    y = conv_w[0] * up[:, :-2] + conv_w[1] * up[:, 1:-1] + conv_w[2] * up[:, 2:]
    return b_g * y


def fourier_mix(u):
    b, n, _ = u.shape
    g = u.astype(jnp.float32).reshape(b, n, N_FGROUPS, FGROUP_DIM)
    y = jnp.fft.fft2(g, axes=(1, 3), norm="ortho").real
    return y.reshape(b, n, FOURIER_W).astype(u.dtype)


def other_branches_and_merge(y_a, z_a, xin, b_g, c_g, z_c, u_f, z_f, gate_logits,
                             conv_w, w_a, w_c, w_f, w_o):
    y_c = short_conv(xin, b_g, c_g, conv_w)
    y_f = fourier_mix(u_f)
    g = jax.nn.sigmoid(gate_logits.astype(jnp.float32)).astype(y_a.dtype)
    g_a, g_c, g_f = jnp.split(g, 3, axis=-1)
    merged = (g_a * ((y_a * jax.nn.silu(z_a)) @ w_a)
              + g_c * ((y_c * jax.nn.silu(z_c)) @ w_c)
              + g_f * ((y_f * jax.nn.silu(z_f)) @ w_f))
    return merged @ w_o


def setup_inputs(seed: int = 0) -> dict:
    key = jax.random.key(seed)
    ks = jax.random.split(key, 16)
    f32 = jnp.float32
    nrm = lambda k, shp: jax.random.normal(k, shp, f32)
    return {
        "x": nrm(ks[0], (BATCH, SEQ, D_MODEL)),
        "c": nrm(ks[1], (BATCH, D_MODEL)),
        "ctx": nrm(ks[2], (BATCH, CTX_LEN, D_MODEL)),
        "c_ctx": nrm(ks[3], (D_MODEL,)),
        "norm_w": 1.0 + 0.02 * nrm(ks[4], (DEPTH, D_MODEL)),
        "w_mod": nrm(ks[5], (DEPTH, D_MODEL, 3 * D_MODEL)) * (0.5 * D_MODEL ** -0.5),
        "b_mod": 0.01 * nrm(ks[6], (DEPTH, 3 * D_MODEL)),
        "w_in": nrm(ks[7], (DEPTH, D_MODEL, PROJ_W)) * D_MODEL ** -0.5,
        "lambda_qk": 0.1 * nrm(ks[8], (DEPTH, 4, HEAD_DIM)),
        "subln_w": 1.0 + 0.02 * nrm(ks[9], (DEPTH, V_DIM)),
        "conv_w": nrm(ks[10], (DEPTH, CONV_K, CONV_W)) * CONV_K ** -0.5,
        "w_attn_o": nrm(ks[11], (DEPTH, ATTN_W, D_MODEL)) * ATTN_W ** -0.5,
        "w_conv_o": nrm(ks[12], (DEPTH, CONV_W, D_MODEL)) * CONV_W ** -0.5,
        "w_four_o": nrm(ks[13], (DEPTH, FOURIER_W, D_MODEL)) * FOURIER_W ** -0.5,
        "w_out": nrm(ks[14], (DEPTH, D_MODEL, D_MODEL)) * D_MODEL ** -0.5,
        "final_norm_w": 1.0 + 0.02 * nrm(ks[15], (D_MODEL,)),
    }


def reference(x, c, ctx, c_ctx, norm_w, w_mod, b_mod, w_in, lambda_qk, subln_w, conv_w,
              w_attn_o, w_conv_o, w_four_o, w_out, final_norm_w):
    ang_r, ang_c = axial_angles(x.shape[1])
    for l in range(DEPTH):
        last = l == DEPTH - 1
        lam_init = 0.8 - 0.6 * math.exp(-0.3 * l)
        lq = lambda_qk[l].astype(jnp.float32)
        lam = jnp.exp(jnp.sum(lq[0] * lq[1])) - jnp.exp(jnp.sum(lq[2] * lq[3])) + lam_init

        sh, sc, gt = adaln(c, w_mod[l], b_mod[l])
        shc, scc, gtc = adaln(c_ctx, w_mod[l], b_mod[l])
        h = rmsnorm(x, norm_w[l]) * (1.0 + sc) + sh
        hc = rmsnorm(ctx, norm_w[l]) * (1.0 + scc) + shc

        (q, k, v, z_a, xin, b_g, c_g, z_c, u_f, z_f, gl) = split_proj(h @ w_in[l])
        (qc, kc, vc, z_ac, xinc, b_gc, c_gc, z_cc, u_fc, z_fc, glc) = split_proj(hc @ w_in[l])

        q_h = axial_rope(qk_heads(q), ang_r, ang_c)
        k_h = axial_rope(qk_heads(k), ang_r, ang_c)
        qc_h, kc_h, vc_h = qk_heads(qc), qk_heads(kc), v_heads(vc)
        k_all = jnp.concatenate([k_h, kc_h], axis=3)
        v_all = jnp.concatenate([v_heads(v), vc_h], axis=2)
        y_a = subln(latent_diff_attn(q_h, k_all, v_all, lam), subln_w[l], lam_init)

        out = other_branches_and_merge(y_a, z_a, xin, b_g, c_g, z_c, u_f, z_f, gl,
                                       conv_w[l], w_attn_o[l], w_conv_o[l], w_four_o[l], w_out[l])

        if not last:
            y_ac = subln(context_diff_attn(qc_h, kc_h, vc_h, lam), subln_w[l], lam_init)
            out_c = other_branches_and_merge(y_ac, z_ac, xinc, b_gc, c_gc, z_cc, u_fc, z_fc, glc,
                                             conv_w[l], w_attn_o[l], w_conv_o[l], w_four_o[l], w_out[l])
            ctx = ctx + gtc * out_c

        x = x + gt * out
    return rmsnorm(x, final_norm_w)
```

```cpp
#include <hip/hip_runtime.h>
#include <hip/hip_cooperative_groups.h>
#include <cstdio>
#include <cstdint>
namespace cg = cooperative_groups;

#define LAS __attribute__((address_space(3)))
typedef unsigned short bf16_t;
typedef short bf16x8 __attribute__((ext_vector_type(8)));
typedef float f32x4 __attribute__((ext_vector_type(4)));
typedef float f32x2 __attribute__((ext_vector_type(2)));
typedef float f32x16 __attribute__((ext_vector_type(16)));
typedef unsigned u32x4 __attribute__((ext_vector_type(4)));
typedef unsigned u32x2 __attribute__((ext_vector_type(2)));
typedef __bf16 bf16x2_t __attribute__((ext_vector_type(2)));

constexpr int D = 1024, NBATCH = 16, SEQ = 2048, CTXL = 256, TB = SEQ + CTXL  , DEPTH = 4;
constexpr int NCH = 2, CB = NBATCH / NCH  , RC = CB * TB  ;
constexpr int N1 = 11264, N2 = 2048, PROJW = 13312;
constexpr int NHEAD = 8;
constexpr float QSCALE = 0.125f * 1.4426950408889634f;
constexpr float LOG2E = 1.4426950408889634f;

constexpr size_t MiB = 1u << 20;
constexpr size_t WS_MOD = 0;
constexpr size_t WS_ROPEC = 835584, WS_ROPES = WS_ROPEC + 4096, WS_LAM = WS_ROPES + 4096;
constexpr size_t WS_NYQ = 828 * 1024, WS_NYQC = 860 * 1024;
constexpr size_t WS_BAR = 896 * 1024, BAR_BYTES = 16384;
constexpr size_t WS_XC = 1 * MiB;
constexpr size_t WS_DFT = 17 * MiB;
constexpr size_t WS_DFTC = 33 * MiB;
constexpr size_t WS_W = 34 * MiB;
constexpr size_t W_LAYER = 40 * MiB, W_T1 = 0, W_T2 = (size_t)N1 * 1024 * 2, W_CAT = W_T2 + 6 * MiB, W_O3 = W_CAT + 6 * MiB;
constexpr size_t WS_SBL = WS_W + W_T2 + 4 * MiB, WS_SBC = WS_W + W_LAYER + W_T2 + 4 * MiB;
constexpr size_t WS_HN = 194 * MiB, WS_QB = 230 * MiB, WS_KB = 266 * MiB, WS_ZA = 302 * MiB, WS_U = 338 * MiB, WS_BZ = 374 * MiB, WS_ZF = 410 * MiB, WS_VT = 446 * MiB;
constexpr size_t WS_YG = WS_QB;
constexpr size_t WS_MRG = 626 * MiB;
constexpr size_t WS_SCR = WS_KB;
constexpr size_t WS_GT = 482 * MiB;
constexpr size_t WS_HT = 590 * MiB;
constexpr size_t WS_HTC = 622 * MiB;
constexpr size_t WS_ACAT = 662 * MiB;
constexpr size_t WS_YGC = 770 * MiB;
constexpr size_t WS_PX = 782 * MiB;
constexpr size_t WS_END = 830 * MiB;
static_assert(W_O3 + 6 * MiB == W_LAYER, "weights");

__device__ __forceinline__ int fresh_tid(int wv) {
  int t = (wv << 6) | (int)__builtin_amdgcn_mbcnt_hi(~0u, __builtin_amdgcn_mbcnt_lo(~0u, 0u)); asm volatile("" : "+v"(t)); return t; }
template <class T> __device__ __forceinline__ T* fresh_ptr(T* p) { __attribute__((address_space(1))) T* g = (__attribute__((address_space(1))) T*)p; asm volatile("" : "+s"(g)); return (T*)g; }
__device__ __forceinline__ unsigned cvt_pk_bf16(float lo, float hi) { f32x2 v = {lo, hi}; bf16x2_t b = __builtin_convertvector(v, bf16x2_t); return __builtin_bit_cast(unsigned, b); }
__device__ __forceinline__ float bf_lo(unsigned w) { return __uint_as_float(w << 16); }
__device__ __forceinline__ float bf_hi(unsigned w) { return __uint_as_float(w & 0xffff0000u); }
__device__ __forceinline__ float fast_sigmoid(float x) { return __builtin_amdgcn_rcpf(1.0f + __builtin_amdgcn_exp2f(-x * LOG2E)); }
__device__ __forceinline__ float fast_silu(float x) { return x * fast_sigmoid(x); }
__device__ __forceinline__ float pl32_sum(float v) { auto rr = __builtin_amdgcn_permlane32_swap(__float_as_uint(v), __float_as_uint(v), false, false); return __uint_as_float(rr[0]) + __uint_as_float(rr[1]); }
__device__ __forceinline__ float pl32_max(float v) { auto rr = __builtin_amdgcn_permlane32_swap(__float_as_uint(v), __float_as_uint(v), false, false); return __builtin_fmaxf(__uint_as_float(rr[0]), __uint_as_float(rr[1])); }
__device__ __forceinline__ float pl32_other(float v, int hi) { auto rr = __builtin_amdgcn_permlane32_swap(__float_as_uint(v), __float_as_uint(v), false, false); return __uint_as_float(hi ? rr[0] : rr[1]); }
__device__ __forceinline__ float wave_sum(float v, int lane) {
#pragma unroll
  for (int o = 1; o < 32; o <<= 1) v += __int_as_float(__builtin_amdgcn_ds_bpermute((lane ^ o) << 2, __float_as_int(v)));
  return pl32_sum(v);
}

namespace pg8 {
constexpr int BM = 256, BK = 64, HALF = 128, HTB = HALF * BK * 2, STAGE_BYTES = 8 * HTB, NXCD = 8, WGM = 8;
__host__ __device__ __forceinline__ int lds_byte(int r, int c) { const int st = (r >> 4) * 2 + (c >> 5), rr = r & 15, cc = c & 31, ob = rr * 64 + cc * 2; return st * 1024 + (ob ^ (((ob >> 9) & 1) << 5)); }
__host__ __device__ __forceinline__ void stage_rc(int b, int& R, int& C) { const int st = b / 1024, sb = b % 1024, swz = sb ^ (((sb >> 9) & 1) << 5); R = (st >> 1) * 16 + swz / 64; C = (st & 1) * 32 + (swz % 64) / 2; }
__host__ __device__ __forceinline__ int perm32(int rho) { const int n = rho >> 4, i = rho & 15; return 8 * (i >> 2) + 4 * n + (i & 3); }

struct Unit { int pm, pn; const char* a; const char* b; const char* b2; };
struct Gemm { int lda, ldb, K; };

struct StaticOrder {
  int nM, nN, nwg, G, c; const char* A; const char* B; size_t ta, tb;
  __device__ void init(const void* A_, const void* B_, int M, int N, int lda, int ldb, int G_, int c_) { nM = M / BM; nN = N / BM; nwg = nM * nN; G = G_; c = c_; A = (const char*)A_; B = (const char*)B_; ta = (size_t)BM * lda * 2; tb = (size_t)BM * ldb * 2; }
  __device__ bool next(int i, Unit& u) const {
    const long L = (long)i * G + c; if (L >= nwg) return false;
    int wgid = (int)L; { const int q = nwg / NXCD, r = nwg % NXCD, xcd = wgid % NXCD, off = wgid / NXCD; wgid = (xcd < r ? xcd * (q + 1) : r * (q + 1) + (xcd - r) * q) + off; }
    const int nig = WGM * nN, gid = wgid / nig, fm = gid * WGM, gsz = (nM - fm) < WGM ? (nM - fm) : WGM;
    u.pm = fm + ((wgid % nig) % gsz); u.pn = (wgid % nig) / gsz; u.a = A + (size_t)u.pm * ta; u.b = B + (size_t)u.pn * tb; return true;
  }
};

template <class Epi, class Sched, bool ALIGN_EPI = true, bool SP2 = true>
__device__ __forceinline__ void gemm_phase(int wv, LAS unsigned char* lds, const Gemm g, const Sched& S, const Epi& E) {
  const int tid = fresh_tid(wv), wid = __builtin_amdgcn_readfirstlane(tid >> 6), lane = tid & 63, wr = wid >> 2, wc = wid & 3, fr = lane & 15, fq = lane >> 4;
  const int K = g.K, nt = K / BK;
  unsigned voffA[2], voffB[2], voffBu[2];
#pragma unroll
  for (int i = 0; i < 2; ++i) { int R, C; stage_rc(tid * 16 + i * 8192, R, C); const int Rb = Epi::PERM ? ((R & ~31) + perm32(R & 31)) : R;
    voffA[i] = (unsigned)(R * g.lda + C) * 2u; voffB[i] = (unsigned)(Rb * g.ldb + C) * 2u;
    if constexpr (Epi::BMODE == 1) voffBu[i] = (unsigned)((127 - Rb) * g.ldb + C) * 2u;
    else voffBu[i] = voffB[i]; }
  const size_t kstep = (size_t)(BK * 2);
  const size_t hstepA = (size_t)HALF * g.lda * 2, hstepB = (size_t)HALF * g.ldb * 2;
  const unsigned ldsw = (unsigned)wid * 1024u;
  const int aoff = lds_byte(wr * 64 + fr, fq * 8), boff = lds_byte(wc * 32 + fr, fq * 8);
#define PG8_SA(b, h) (((b) * 2 + (h)) * HTB)
#define PG8_SB(b, h) ((4 + (b) * 2 + (h)) * HTB)
#define PG8_STAGE(bufoff, gbase, voff) do { _Pragma("unroll") for (int _i = 0; _i < 2; ++_i) \
    __builtin_amdgcn_global_load_lds((const unsigned*)((const char*)(gbase) + (voff)[_i]), (LAS unsigned*)(lds + (bufoff) + ldsw + _i * 8192), 16, 0, 0); } while (0)
#define PG8_LDA(dst, b, h) do { _Pragma("unroll") for (int m = 0; m < 4; ++m) _Pragma("unroll") for (int k = 0; k < 2; ++k) dst[m][k] = *(const LAS bf16x8*)(lds + PG8_SA(b, h) + aoff + m * 2048 + k * 1024); } while (0)
#define PG8_LDB(dst, b, h) do { _Pragma("unroll") for (int n = 0; n < 2; ++n) _Pragma("unroll") for (int k = 0; k < 2; ++k) dst[n][k] = *(const LAS bf16x8*)(lds + PG8_SB(b, h) + boff + n * 2048 + k * 1024); } while (0)
#define PG8_MMA(ai, bj, At, Bt) do { __builtin_amdgcn_s_setprio(1); _Pragma("unroll") for (int m = 0; m < 4; ++m) _Pragma("unroll") for (int n = 0; n < 2; ++n) _Pragma("unroll") for (int k = 0; k < 2; ++k) \
    acc[ai][bj][m][n] = __builtin_amdgcn_mfma_f32_16x16x32_bf16(Bt[n][k], At[m][k], acc[ai][bj][m][n], 0, 0, 0); __builtin_amdgcn_s_setprio(0); } while (0)
#define PG8_WAIT_V(n) asm volatile("s_waitcnt vmcnt(" #n ")" ::: "memory")
#define PG8_WAIT_L(n) asm volatile("s_waitcnt lgkmcnt(" #n ")" ::: "memory")
#define PG8_BAR __builtin_amdgcn_s_barrier()
#define PG8_SCHED __builtin_amdgcn_sched_barrier(0)
  Unit cur, nxt; int ui = 0;
  if (!S.next(0, cur)) return;
  f32x4 acc[2][2][4][2];
#pragma unroll
  for (int a = 0; a < 2; ++a)
#pragma unroll
    for (int b = 0; b < 2; ++b)
#pragma unroll
      for (int m = 0; m < 4; ++m)
#pragma unroll
        for (int n = 0; n < 2; ++n) acc[a][b][m][n] = (f32x4){0.f, 0.f, 0.f, 0.f};
  bf16x8 At[4][2], B0[2][2], B1[2][2];
  const char* cA = cur.a; const char* cB = cur.b; const char* cBu = (Epi::BMODE == 1) ? cur.b2 : cur.b + hstepB;
  static_assert(SP2, "only the SP2 loop is kept");
  PG8_STAGE(PG8_SB(0, 0), cB, voffB); PG8_STAGE(PG8_SB(0, 1), cBu, voffBu); PG8_STAGE(PG8_SA(0, 0), cA, voffA); PG8_STAGE(PG8_SA(0, 1), cA + hstepA, voffA);
  if (wr == 1) PG8_BAR;
  PG8_WAIT_V(2); PG8_BAR;
  PG8_STAGE(PG8_SB(1, 0), cB + kstep, voffB); PG8_STAGE(PG8_SA(1, 0), cA + kstep, voffA); PG8_STAGE(PG8_SB(1, 1), cBu + kstep, voffBu);
  PG8_WAIT_V(6); PG8_BAR;
  for (;;) {
    const bool has_next = S.next(ui + 1, nxt);
    const char* nA = has_next ? nxt.a : cA; const char* nB = has_next ? nxt.b : cB;
    const char* nBu = has_next ? ((Epi::BMODE == 1) ? nxt.b2 : nxt.b + hstepB) : cBu;
    for (int t = 0; t < nt; t += 2) {
      const bool last = (t == nt - 2);
      const char* a1 = cA + (size_t)(t + 1) * kstep;
      const char* a2 = last ? nA : cA + (size_t)(t + 2) * kstep; const char* b2 = last ? nB : cB + (size_t)(t + 2) * kstep;
      const char* a3 = a2 + kstep; const char* b3 = b2 + kstep;
      const char* b2u = last ? nBu : cBu + (size_t)(t + 2) * kstep; const char* b3u = b2u + kstep;
      PG8_LDB(B0, 0, 0); PG8_LDB(B1, 0, 1); PG8_SCHED; PG8_LDA(At, 0, 0); PG8_STAGE(PG8_SA(1, 1), a1 + hstepA, voffA);
      PG8_WAIT_V(8); PG8_WAIT_L(0); PG8_BAR; PG8_MMA(0, 0, At, B0); PG8_MMA(0, 1, At, B1); PG8_BAR; PG8_SCHED;
      PG8_LDA(At, 0, 1); PG8_STAGE(PG8_SB(0, 0), b2, voffB); PG8_STAGE(PG8_SB(0, 1), b2u, voffBu); PG8_STAGE(PG8_SA(0, 0), a2, voffA);
      PG8_WAIT_V(8); PG8_WAIT_L(0); PG8_BAR; PG8_MMA(1, 0, At, B0); PG8_MMA(1, 1, At, B1); PG8_BAR; PG8_SCHED;
      PG8_LDB(B0, 1, 0); PG8_LDB(B1, 1, 1); PG8_SCHED; PG8_LDA(At, 1, 0); PG8_STAGE(PG8_SA(0, 1), a2 + hstepA, voffA);
      PG8_WAIT_V(8); PG8_WAIT_L(0); PG8_BAR; PG8_MMA(0, 0, At, B0); PG8_MMA(0, 1, At, B1); PG8_BAR; PG8_SCHED;
      PG8_LDA(At, 1, 1); PG8_STAGE(PG8_SB(1, 0), b3, voffB); PG8_STAGE(PG8_SB(1, 1), b3u, voffBu); PG8_STAGE(PG8_SA(1, 0), a3, voffA);
      PG8_WAIT_V(8); PG8_WAIT_L(0); PG8_BAR; PG8_MMA(1, 0, At, B0); PG8_MMA(1, 1, At, B1); PG8_BAR; PG8_SCHED;
    }
    if constexpr (ALIGN_EPI) { if (wr == 0) PG8_BAR; }
    E(acc, cur, wr, wc, fr, fq);
    if (!has_next) break;
#pragma unroll
    for (int a = 0; a < 2; ++a)
#pragma unroll
      for (int b = 0; b < 2; ++b)
#pragma unroll
        for (int m = 0; m < 4; ++m)
#pragma unroll
          for (int n = 0; n < 2; ++n) acc[a][b][m][n] = (f32x4){0.f, 0.f, 0.f, 0.f};
    cur = nxt; cA = nA; cB = nB; cBu = nBu; ++ui;
    if constexpr (ALIGN_EPI) { if (wr == 1) PG8_BAR; }
  }
  PG8_WAIT_V(0);
  if constexpr (!ALIGN_EPI) { if (wr == 0) PG8_BAR; }
  PG8_BAR;
#undef PG8_SA
#undef PG8_SB
#undef PG8_STAGE
#undef PG8_LDA
#undef PG8_LDB
#undef PG8_MMA
#undef PG8_WAIT_V
#undef PG8_WAIT_L
#undef PG8_BAR
#undef PG8_SCHED
}
}

#define XB_TMO      128
#define XB_XCNT(j)  (256  + 64 * (j))
#define XB_XSUB(j)  (1280 + 64 * (j))
#define XB_XGEN(j)  (2304 + 64 * (j))
#define XB_TOP      3328
#define XB_TOPGEN   3392
#define XCD_BAR_WORDS 3456
#define XB_SPIN_CAP (1u << 22)
__device__ __forceinline__ unsigned xb_ld(unsigned* p)              { return __hip_atomic_load(p, __ATOMIC_RELAXED, __HIP_MEMORY_SCOPE_AGENT); }
__device__ __forceinline__ unsigned xb_add(unsigned* p, unsigned v) { return __hip_atomic_fetch_add(p, v, __ATOMIC_RELAXED, __HIP_MEMORY_SCOPE_AGENT); }
__device__ __forceinline__ unsigned xb_xcc_id() { return (unsigned)__builtin_amdgcn_s_getreg((3 << 11) | 20) & 0xFu; }
#define XB_SPIN(cond, bar) do { unsigned _sp = 0; while (cond) { __builtin_amdgcn_s_sleep(1); \
    if ((++_sp & 255u) == 0u) { if (xb_ld(&(bar)[XB_TMO])) break; if (_sp > XB_SPIN_CAP) { atomicAdd(&(bar)[XB_TMO], 1u); break; } } } } while (0)
struct XcdBarrier { unsigned* bar; unsigned x; volatile LAS unsigned* st; };
__device__ __forceinline__ XcdBarrier xcd_barrier_post(unsigned* bar, volatile LAS unsigned* st) {
  XcdBarrier b; b.bar = bar; b.x = xb_xcc_id(); b.st = st;
  if (threadIdx.x == 0) (void)xb_add(&bar[XB_XCNT(b.x)], 1u);
  return b;
}
__device__ __forceinline__ void xcd_barrier_complete(unsigned* bar, unsigned x, unsigned& nloc, unsigned& nx) {
  const unsigned G = gridDim.x * gridDim.y * gridDim.z;
  unsigned sum, cnt, mine, sp = 0u;
  for (;;) {
    sum = 0u; cnt = 0u; mine = 0u;
#pragma unroll
    for (unsigned j = 0; j < 16; ++j) { const unsigned c = xb_ld(&bar[XB_XCNT(j)]); sum += c; cnt += (c > 0u) ? 1u : 0u; mine = (j == x) ? c : mine; }
    if (sum == G) break;
    __builtin_amdgcn_s_sleep(1);
    if ((++sp & 255u) == 0u) { if (xb_ld(&bar[XB_TMO])) break; if (sp > XB_SPIN_CAP) { atomicAdd(&bar[XB_TMO], 1u); break; } }
  }
  nloc = mine > 0u ? mine : 1u; nx = cnt > 0u ? cnt : 1u;
}
__device__ __forceinline__ void xcd_barrier(const XcdBarrier& b, int wv) {
  asm volatile("s_waitcnt vmcnt(0)" ::: "memory");
  __syncthreads();
  if (wv == 0 && __builtin_amdgcn_mbcnt_hi(~0u, __builtin_amdgcn_mbcnt_lo(~0u, 0u)) == 0u) {
    unsigned* bar = fresh_ptr(b.bar); unsigned bxx = __builtin_amdgcn_readfirstlane(b.x); asm volatile("" : "+s"(bxx));
    __builtin_amdgcn_s_waitcnt(0);
    unsigned nloc = b.st[0], nx = b.st[1];
    if (nloc == 0u) { xcd_barrier_complete(bar, bxx, nloc, nx); b.st[0] = nloc; b.st[1] = nx; }
    const unsigned old = xb_add(&bar[XB_XSUB(bxx)], 1u);
    const unsigned gen = old / nloc;
    if (old + 1u == (gen + 1u) * nloc) {
      __builtin_amdgcn_fence(__ATOMIC_RELEASE, "agent");
      asm volatile("s_waitcnt vmcnt(0)" ::: "memory");
      const unsigned og = xb_add(&bar[XB_TOP], 1u);
      const unsigned tg = og / nx;
      if (og + 1u == (tg + 1u) * nx) xb_add(&bar[XB_TOPGEN], 1u);
      else XB_SPIN(xb_ld(&bar[XB_TOPGEN]) == tg, bar);
      __builtin_amdgcn_fence(__ATOMIC_ACQUIRE, "agent");
      xb_add(&bar[XB_XGEN(bxx)], 1u);
      asm volatile("s_waitcnt vmcnt(0)" ::: "memory");
    } else {
      XB_SPIN(xb_ld(&bar[XB_XGEN(bxx)]) == gen, bar);
      __builtin_amdgcn_fence(__ATOMIC_ACQUIRE, "agent");
      asm volatile("s_waitcnt vmcnt(0)" ::: "memory");
    }
  }
  __syncthreads();
}

__device__ __forceinline__ int lat_pm(int j) { return (j >> 3) * 9 + (j & 7); }
struct PlainOrder : pg8::StaticOrder {
  int adiv; size_t acol; int lat;
  __device__ void init2(const void* A_, const void* B_, int M, int N, int lda, int ldb, int G_, int c_, int adiv_ = 1 << 30, size_t acol_ = 0, int lat_ = 0) { init(A_, B_, M, N, lda, ldb, G_, c_); adiv = adiv_; acol = acol_; lat = lat_; }
  __device__ bool next(int i, pg8::Unit& u) const {
    if (!pg8::StaticOrder::next(i, u)) {
      const long L = (long)i * G + c - nwg; if (lat != 2 || L < 0 || L >= 32) return false;
      u.pm = (int)(L >> 2) * 9 + 8; u.pn = 4 + (int)(L & 3); u.a = A + (size_t)u.pm * ta; u.b = B + (size_t)u.pn * tb; return true; }
    if (lat) { u.pm = lat_pm(u.pm); u.a = A + (size_t)u.pm * ta; } u.a += (size_t)(u.pn / adiv) * acol; return true; }
};
struct CtxKOrder {
  int G, c; const char* A; const char* B;
  __device__ bool next(int i, pg8::Unit& u) const { const int L = i * G + c; if (L >= 32) return false; u.pm = (L >> 2) * 9 + 8; u.pn = 4 + (L & 3);
    u.a = A + (size_t)u.pm * 256 * 2048; u.b = B + (size_t)u.pn * 256 * 2048; return true; }
};
struct BatchOrder {
  int nb, nM, nN, G, c, pm_off; const char* A; const char* B; size_t ta, bb, tb;
  __device__ bool next(int i, pg8::Unit& u) const {
    const long L = (long)i * G + c; if (L >= (long)nb * nM * nN) return false;
    const int bl = (int)(L % nb), rem = (int)(L / nb), pn = rem % nN, pml = rem / nN;
    u.pm = bl * 9 + pm_off + pml; u.pn = pn; u.a = A + (size_t)pml * ta; u.b = B + (size_t)bl * bb + (size_t)pn * tb; return true;
  }
};

__device__ __forceinline__ void st8(bf16_t* p, f32x4 v0, f32x4 v1) { u32x4 w; w.x = cvt_pk_bf16(v0[0], v0[1]); w.y = cvt_pk_bf16(v0[2], v0[3]); w.z = cvt_pk_bf16(v1[0], v1[1]); w.w = cvt_pk_bf16(v1[2], v1[3]); *(u32x4*)p = w; }
__device__ __forceinline__ f32x4 silu4(f32x4 v) { return (f32x4){fast_silu(v[0]), fast_silu(v[1]), fast_silu(v[2]), fast_silu(v[3])}; }
__device__ __forceinline__ f32x4 sigm4(f32x4 v) { return (f32x4){fast_sigmoid(v[0]), fast_sigmoid(v[1]), fast_sigmoid(v[2]), fast_sigmoid(v[3])}; }
__device__ __forceinline__ void ld8(const bf16_t* p, f32x4& a, f32x4& b) { const u32x4 w = *(const u32x4*)p; a = (f32x4){bf_lo(w.x), bf_hi(w.x), bf_lo(w.y), bf_hi(w.y)}; b = (f32x4){bf_lo(w.z), bf_hi(w.z), bf_lo(w.w), bf_hi(w.w)}; }

struct EpiMain {
  static constexpr bool PERM = true; static constexpr int BMODE = 0;
  bf16_t *QB, *KB, *ZA, *U, *BZ, *ZF, *GT; const float *ropec, *ropes;
  __device__ __forceinline__ void operator()(const f32x4 (&acc)[2][2][4][2], const pg8::Unit& u, int wr, int wc, int fr, int fq) const {
    const int pn = u.pn; const size_t row0 = (size_t)u.pm * 256 + wr * 64 + fr; const int cin = wc * 32 + 8 * fq;
    if (pn < 8) {
      const bool isq = pn < 4; bf16_t* O = isq ? QB : KB; const int colt = (pn & 3) * 256;
      const int t9 = u.pm % 9; const bool ctx = (t9 == 8);
      const float sc = isq ? QSCALE : 1.0f;
#pragma unroll
      for (int ai = 0; ai < 2; ++ai)
#pragma unroll
        for (int m = 0; m < 4; ++m) {
          const int p = (wc & 1) ? (16 * m + fr) : (4 * t9 + 2 * ai + wr);
          f32x4 cs = {1.f, 1.f, 1.f, 1.f}, sn = {0.f, 0.f, 0.f, 0.f};
          if (!ctx) { cs = *(const f32x4*)(ropec + p * 16 + 4 * fq); sn = *(const f32x4*)(ropes + p * 16 + 4 * fq); }
#pragma unroll
          for (int bj = 0; bj < 2; ++bj) {
            const f32x4 x1 = acc[ai][bj][m][0], x2 = acc[ai][bj][m][1];
            const f32x4 v0 = (x1 * cs - x2 * sn) * sc, v1 = (x2 * cs + x1 * sn) * sc;
            st8(O + (row0 + ai * 128 + m * 16) * 1024 + colt + bj * 128 + cin, v0, v1);
          }
        }
    } else if (pn < 12 || (pn >= 28 && pn < 32)) {
      bf16_t* O = pn < 12 ? ZA : ZF; const int colt = (pn < 12 ? pn - 8 : pn - 28) * 256;
#pragma unroll
      for (int ai = 0; ai < 2; ++ai)
#pragma unroll
        for (int m = 0; m < 4; ++m)
#pragma unroll
          for (int bj = 0; bj < 2; ++bj)
            st8(O + (row0 + ai * 128 + m * 16) * 1024 + colt + bj * 128 + cin, silu4(acc[ai][bj][m][0]), silu4(acc[ai][bj][m][1]));
    } else if (pn < 20) {
      const int colt = (pn - 12) * 128;
#pragma unroll
      for (int ai = 0; ai < 2; ++ai)
#pragma unroll
        for (int m = 0; m < 4; ++m)
          st8(U + (row0 + ai * 128 + m * 16) * 1024 + colt + cin, acc[ai][0][m][0] * acc[ai][1][m][0], acc[ai][0][m][1] * acc[ai][1][m][1]);
    } else if (pn < 28) {
      const int colt = (pn - 20) * 128;
#pragma unroll
      for (int ai = 0; ai < 2; ++ai)
#pragma unroll
        for (int m = 0; m < 4; ++m)
          st8(BZ + (row0 + ai * 128 + m * 16) * 1024 + colt + cin, acc[ai][0][m][0] * silu4(acc[ai][1][m][0]), acc[ai][0][m][1] * silu4(acc[ai][1][m][1]));
    } else {
      const int colt = (pn - 32) * 256;
#pragma unroll
      for (int ai = 0; ai < 2; ++ai)
#pragma unroll
        for (int m = 0; m < 4; ++m)
#pragma unroll
          for (int bj = 0; bj < 2; ++bj)
            st8(GT + (row0 + ai * 128 + m * 16) * 3072 + colt + bj * 128 + cin, sigm4(acc[ai][bj][m][0]), sigm4(acc[ai][bj][m][1]));
    }
  }
};

struct EpiT {
  static constexpr bool PERM = true; static constexpr int BMODE = 0;
  bf16_t *VT, *HT, *HTC;
  __device__ __forceinline__ void operator()(const f32x4 (&acc)[2][2][4][2], const pg8::Unit& u, int wr, int wc, int fr, int fq) const {
    const int cin = wc * 32 + 8 * fq; const int bl = u.pn / 9, t9 = u.pn % 9;
    if (u.pm < 4) {
      const int ch0 = u.pm * 256 + wr * 64 + fr; bf16_t* base = VT + (size_t)bl * 1024 * TB + t9 * 256;
#pragma unroll
      for (int ai = 0; ai < 2; ++ai)
#pragma unroll
        for (int m = 0; m < 4; ++m)
#pragma unroll
          for (int bj = 0; bj < 2; ++bj)
            st8(base + (size_t)(ch0 + ai * 128 + m * 16) * TB + bj * 128 + cin, acc[ai][bj][m][0], acc[ai][bj][m][1]);
    } else {
      bf16_t* base; size_t ld; int sinoff;
      if (t9 < 8) { base = HT + (size_t)bl * 1024 * 4096 + t9 * 256; ld = 4096; sinoff = 2048; } else { base = HTC + (size_t)bl * 1024 * 512; ld = 512; sinoff = 256; }
#pragma unroll
      for (int ai = 0; ai < 2; ++ai) {
        const int g = (u.pm - 4) * 2 + ai;
#pragma unroll
        for (int m = 0; m < 4; ++m) {
          const int s = wr * 64 + m * 16 + fr; const bool is_cos = s <= 64; const int k2 = is_cos ? s : s - 64; const bool edge = (k2 == 0) || (k2 == 64);
          bf16_t* p1 = base + (size_t)(g * 128 + k2) * ld + (is_cos ? 0 : sinoff) + cin;
          bf16_t* p2 = edge ? base + (size_t)(g * 128 + k2) * ld + sinoff + cin : base + (size_t)(g * 128 + 128 - k2) * ld + (is_cos ? 0 : sinoff) + cin;
          const float sg = edge ? 0.f : (is_cos ? 1.f : -1.f);
#pragma unroll
          for (int bj = 0; bj < 2; ++bj) { st8(p1 + bj * 128, acc[ai][bj][m][0], acc[ai][bj][m][1]); st8(p2 + bj * 128, acc[ai][bj][m][0] * sg, acc[ai][bj][m][1] * sg); }
        }
      }
    }
  }
};

struct EpiMulBf16 {
  static constexpr bool PERM = true; static constexpr int BMODE = 0;
  bf16_t* O; const bf16_t* Mul; int ldo, ldm, ooff, moff, octx;
  __device__ __forceinline__ void operator()(const f32x4 (&acc)[2][2][4][2], const pg8::Unit& u, int wr, int wc, int fr, int fq) const {
    const size_t row0 = (size_t)u.pm * 256 + wr * 64 + fr; const int col0 = u.pn * 256 + wc * 32 + 8 * fq;
    const size_t orow0 = octx ? (size_t)(u.pm / 9) * 256 + wr * 64 + fr : row0;
#pragma unroll
    for (int ai = 0; ai < 2; ++ai) {
      u32x4 gw[4][2];
#pragma unroll
      for (int m = 0; m < 4; ++m)
#pragma unroll
        for (int bj = 0; bj < 2; ++bj) gw[m][bj] = *(const u32x4*)(Mul + (row0 + ai * 128 + m * 16) * ldm + moff + col0 + bj * 128);
#pragma unroll
      for (int m = 0; m < 4; ++m)
#pragma unroll
        for (int bj = 0; bj < 2; ++bj) {
          const u32x4 w = gw[m][bj];
          const f32x4 g0 = {bf_lo(w.x), bf_hi(w.x), bf_lo(w.y), bf_hi(w.y)}, g1 = {bf_lo(w.z), bf_hi(w.z), bf_lo(w.w), bf_hi(w.w)};
          st8(O + (orow0 + ai * 128 + m * 16) * ldo + ooff + col0 + bj * 128, acc[ai][bj][m][0] * g0, acc[ai][bj][m][1] * g1);
        }
      asm volatile("" ::: "memory");
    }
  }
};

struct TripleOrder {
  pg8::StaticOrder so; const char* W; int lat;
  __device__ bool next(int i, pg8::Unit& u) const {
    const int br = i % 3;
    if (!so.next(i / 3, u)) return false;
    if (lat) { u.pm = lat_pm(u.pm); u.a = so.A + (size_t)u.pm * so.ta; }
    u.a += (size_t)br * 2048; u.b = W + ((size_t)br * 1024 + (size_t)u.pn * 256) * 1024 * 2; u.pn |= br << 8; return true;
  }
};
struct EpiAcc {
  static constexpr bool PERM = true; static constexpr int BMODE = 0;
  bf16_t* Mout; const bf16_t* GT; float* scr;
  __device__ __forceinline__ void operator()(const f32x4 (&acc)[2][2][4][2], const pg8::Unit& u, int wr, int wc, int fr, int fq) const {
    const int br = u.pn >> 8, pn = u.pn & 255; const int tid = (wr * 4 + wc) * 64 + fq * 16 + fr;
    const size_t row0 = (size_t)u.pm * 256 + wr * 64 + fr; const int col0 = pn * 256 + wc * 32 + 8 * fq;
    u32x4* sp0 = (u32x4*)scr + tid;
#pragma unroll
    for (int ai = 0; ai < 2; ++ai) {
      __attribute__((address_space(1))) u32x4* sp = (__attribute__((address_space(1))) u32x4*)sp0; asm volatile("" : "+v"(sp));
      u32x4 gw[4][2], sw[4][2];
#pragma unroll
      for (int m = 0; m < 4; ++m)
#pragma unroll
        for (int bj = 0; bj < 2; ++bj) gw[m][bj] = *(const u32x4*)(GT + (row0 + ai * 128 + m * 16) * 3072 + br * 1024 + col0 + bj * 128);
      if (br > 0) {
#pragma unroll
        for (int m = 0; m < 4; ++m)
#pragma unroll
          for (int bj = 0; bj < 2; ++bj) sw[m][bj] = sp[(size_t)((ai * 4 + m) * 2 + bj) * 512];
      }
#pragma unroll
      for (int m = 0; m < 4; ++m)
#pragma unroll
        for (int bj = 0; bj < 2; ++bj) {
          const u32x4 w = gw[m][bj];
          const f32x4 g0 = {bf_lo(w.x), bf_hi(w.x), bf_lo(w.y), bf_hi(w.y)}, g1 = {bf_lo(w.z), bf_hi(w.z), bf_lo(w.w), bf_hi(w.w)};
          f32x4 v0 = acc[ai][bj][m][0] * g0, v1 = acc[ai][bj][m][1] * g1;
          if (br > 0) { const u32x4 s = sw[m][bj]; v0 += (f32x4){bf_lo(s.x), bf_hi(s.x), bf_lo(s.y), bf_hi(s.y)}; v1 += (f32x4){bf_lo(s.z), bf_hi(s.z), bf_lo(s.w), bf_hi(s.w)}; }
          u32x4 o; o.x = cvt_pk_bf16(v0[0], v0[1]); o.y = cvt_pk_bf16(v0[2], v0[3]); o.z = cvt_pk_bf16(v1[0], v1[1]); o.w = cvt_pk_bf16(v1[2], v1[3]);
          if (br < 2) sp[(size_t)((ai * 4 + m) * 2 + bj) * 512] = o;
          else *(u32x4*)(Mout + (row0 + ai * 128 + m * 16) * 1024 + col0 + bj * 128) = o;
        }
      asm volatile("" ::: "memory");
    }
  }
};

struct EpiRes {
  static constexpr bool PERM = false; static constexpr int BMODE = 0;
  const float *base_lat, *base_ctx; float *out_lat, *out_ctx; const float* mod; int chunk;
  __device__ __forceinline__ void operator()(const f32x4 (&acc)[2][2][4][2], const pg8::Unit& u, int wr, int wc, int fr, int fq) const {
    const int bl = u.pm / 9, t9 = u.pm % 9, b = chunk * CB + bl; const bool ctx = (t9 == 8);
    const size_t rbase = ctx ? (size_t)b * CTXL : (size_t)b * SEQ + t9 * 256;
    const __attribute__((address_space(1))) float* bs = (const __attribute__((address_space(1))) float*)(ctx ? base_ctx : base_lat) + rbase * 1024; __attribute__((address_space(1))) float* os = (__attribute__((address_space(1))) float*)(ctx ? out_ctx : out_lat) + rbase * 1024;
    const float* gate = mod + (size_t)(ctx ? 16 : b) * 3072 + 2048;
    const int col0 = u.pn * 256 + wc * 32 + 4 * fq;
#pragma unroll
    for (int bj = 0; bj < 2; ++bj)
#pragma unroll
      for (int n = 0; n < 2; ++n) {
        const f32x4 gv = *(const f32x4*)(gate + col0 + bj * 128 + n * 16);
        f32x4 xv[2][4];
#pragma unroll
        for (int ai = 0; ai < 2; ++ai)
#pragma unroll
          for (int m = 0; m < 4; ++m) xv[ai][m] = *(const __attribute__((address_space(1))) f32x4*)(bs + (size_t)(ai * 128 + wr * 64 + m * 16 + fr) * 1024 + col0 + bj * 128 + n * 16);
#pragma unroll
        for (int ai = 0; ai < 2; ++ai)
#pragma unroll
          for (int m = 0; m < 4; ++m) *(__attribute__((address_space(1))) f32x4*)(os + (size_t)(ai * 128 + wr * 64 + m * 16 + fr) * 1024 + col0 + bj * 128 + n * 16) = xv[ai][m] + gv * acc[ai][bj][m][n];
        asm volatile("" ::: "memory");
      }
  }
};

struct CtxOrder {
  int G, c; const char* A; const char* B; size_t ta, tb; int ctxA, bsplit;
  __device__ bool next(int i, pg8::Unit& u) const {
    const int L = i * G + c; if (L >= 96) return false;
    const int j = L / 12, q = L % 12, br = q >> 2;
    u.pm = j * 9 + 8; u.pn = bsplit ? q : ((q & 3) | (br << 8));
    u.a = A + (size_t)(ctxA ? j : u.pm) * ta + (size_t)br * 2048; u.b = B + (size_t)(bsplit ? q : (q & 3)) * tb; return true;
  }
};
struct EpiPart {
  static constexpr bool PERM = false; static constexpr int BMODE = 0;
  float* PX;
  __device__ __forceinline__ void operator()(const f32x4 (&acc)[2][2][4][2], const pg8::Unit& u, int wr, int wc, int fr, int fq) const {
    const int br = u.pn >> 8, pn = u.pn & 255;
    __attribute__((address_space(1))) float* os = (__attribute__((address_space(1))) float*)PX + ((size_t)br * 2048 + (size_t)(u.pm / 9) * 256) * 1024;
    const int col0 = pn * 256 + wc * 32 + 4 * fq;
#pragma unroll
    for (int bj = 0; bj < 2; ++bj)
#pragma unroll
      for (int n = 0; n < 2; ++n)
#pragma unroll
        for (int ai = 0; ai < 2; ++ai)
#pragma unroll
          for (int m = 0; m < 4; ++m)
            *(__attribute__((address_space(1))) f32x4*)(os + (size_t)(ai * 128 + wr * 64 + m * 16 + fr) * 1024 + col0 + bj * 128 + n * 16) = acc[ai][bj][m][n];
  }
};


struct MirrorOrder {
  int G, c; const char* A; const char* HNb; const char* SBLb; const char* SBCb;
  __device__ bool next(int i, pg8::Unit& u) const {
    const int L = i * G + c; if (L >= 288) return false;
    const int ft = L & 3, tt = L >> 2, bl = tt / 9, t9 = tt % 9; const size_t rowb = (size_t)bl * TB;
    u.pm = 4 + ft; u.pn = tt; u.a = A + (size_t)(1024 + ft * 256) * 2048;
    if (t9 == 0) { u.b = HNb + rowb * 2048; u.b2 = SBLb + (size_t)bl * 128 * 2048; }
    else if (t9 < 8) { u.b = HNb + (rowb + 128 * t9) * 2048; u.b2 = HNb + (rowb + SEQ - 128 * t9 - 127) * 2048; }
    else { u.b = HNb + (rowb + SEQ) * 2048; u.b2 = SBCb + (size_t)bl * 128 * 2048; }
    return true;
  }
};
struct EpiT2 {
  static constexpr bool PERM = true; static constexpr int BMODE = 1;
  bf16_t *HT, *HTC; float *NYQ, *NYQC;
  __device__ __forceinline__ void operator()(const f32x4 (&acc)[2][2][4][2], const pg8::Unit& u, int wr, int wc, int fr, int fq) const {
    asm volatile("" : "+v"(fr), "+v"(fq), "+s"(wr), "+s"(wc));
    const int ft = u.pm - 4, bl = u.pn / 9, t9 = u.pn % 9, j0 = wc * 32 + 8 * fq;
    bf16_t* base; size_t ld; int sinoff, n0;
    if (t9 < 8) { base = HT + (size_t)bl * 1024 * 2048; ld = 2048; sinoff = 1024; n0 = 128 * t9; } else { base = HTC + (size_t)bl * 1024 * 256; ld = 256; sinoff = 128; n0 = 0; }
    const bool first = (n0 == 0) && (j0 == 0);
#pragma unroll
    for (int ai = 0; ai < 2; ++ai) {
      const int g = ft * 2 + ai;
#pragma unroll
      for (int m = 0; m < 4; ++m) {
        const int s = wr * 64 + m * 16 + fr; const bool is_cos = s <= 64; const int k2 = is_cos ? s : s - 64; const bool edge = (k2 == 0) || (k2 == 64);
        const f32x4 a0 = acc[ai][0][m][0], a1 = acc[ai][0][m][1], b0 = acc[ai][1][m][0], b1 = acc[ai][1][m][1];
        f32x4 v0 = is_cos ? a0 + b0 : a0 - b0; const f32x4 v1 = is_cos ? a1 + b1 : a1 - b1;
        if (first) { v0[0] = is_cos ? a0[0] : 0.f;
          if (is_cos) { float* nq = NYQ + (t9 < 8 ? 0 : (int)((WS_NYQC - WS_NYQ) / 4)) + bl * 1024 + g * 128; nq[k2] = b0[0]; if (!edge) nq[128 - k2] = b0[0]; } }
        bf16_t* p1 = base + (size_t)(g * 128 + k2) * ld + (is_cos ? 0 : sinoff) + n0 + j0;
        bf16_t* p2 = edge ? base + (size_t)(g * 128 + k2) * ld + sinoff + n0 + j0 : base + (size_t)(g * 128 + 128 - k2) * ld + (is_cos ? 0 : sinoff) + n0 + j0;
        const float sg = edge ? 0.f : (is_cos ? 1.f : -1.f);
        st8(p1, v0, v1); st8(p2, v0 * sg, v1 * sg);
      }
    }
  }
};
struct EpiFour {
  static constexpr bool PERM = true; static constexpr int BMODE = 0;
  bf16_t* O; const bf16_t* ZF; const float *NYQ, *NYQC;
  __device__ __forceinline__ void operator()(const f32x4 (&acc)[2][2][4][2], const pg8::Unit& u, int wr, int wc, int fr, int fq) const {
    const size_t row0 = (size_t)u.pm * 256 + wr * 64 + fr; const int col0 = u.pn * 256 + wc * 32 + 8 * fq;
    const int bl = u.pm / 9; const bool ctx = (u.pm % 9) == 8;
    const float* nq = (ctx ? NYQC : NYQ) + (size_t)bl * 1024 + col0;
    const float sc = (ctx ? 0.0625f : 0.022097086912079608f) * ((fr & 1) ? -1.f : 1.f);
    f32x4 ny[2][2];
#pragma unroll
    for (int bj = 0; bj < 2; ++bj) { ny[bj][0] = *(const f32x4*)(nq + bj * 128) * sc; ny[bj][1] = *(const f32x4*)(nq + bj * 128 + 4) * sc; }
#pragma unroll
    for (int ai = 0; ai < 2; ++ai) {
      u32x4 gw[4][2];
#pragma unroll
      for (int m = 0; m < 4; ++m)
#pragma unroll
        for (int bj = 0; bj < 2; ++bj) gw[m][bj] = *(const u32x4*)(ZF + (row0 + ai * 128 + m * 16) * 1024 + col0 + bj * 128);
#pragma unroll
      for (int m = 0; m < 4; ++m)
#pragma unroll
        for (int bj = 0; bj < 2; ++bj) {
          const u32x4 w = gw[m][bj];
          const f32x4 g0 = {bf_lo(w.x), bf_hi(w.x), bf_lo(w.y), bf_hi(w.y)}, g1 = {bf_lo(w.z), bf_hi(w.z), bf_lo(w.w), bf_hi(w.w)};
          st8(O + (row0 + ai * 128 + m * 16) * 3072 + 2048 + col0 + bj * 128, (acc[ai][bj][m][0] + ny[bj][0]) * g0, (acc[ai][bj][m][1] + ny[bj][1]) * g1);
        }
      asm volatile("" ::: "memory");
    }
  }
};

namespace att {
constexpr int KSTR = 272, VSTR = 136, KBYTES = 64 * KSTR, VBYTES = 128 * VSTR, STG = KBYTES + VBYTES;
constexpr int EXSTR = 132, YT_OFF = 2 * STG, YTSTR = 272;
__device__ __forceinline__ int crow(int r, int hi) { return (r & 3) + 8 * (r >> 2) + 4 * hi; }
#define MFMA32(a, b, c) __builtin_amdgcn_mfma_f32_32x32x16_bf16((a), (b), (c), 0, 0, 0)

__device__ __forceinline__ void attn_unit(int wv, LAS unsigned char* lds, const bf16_t* __restrict__ Qb, const bf16_t* __restrict__ Kb, const bf16_t* __restrict__ Vt, const bf16_t* __restrict__ ZA, bf16_t* __restrict__ ACAT,
                                          int bl, int head, int q0, int key0, int nkeys, int lam_bits, int lami_bits, const float* __restrict__ subw) {
  const int tid = fresh_tid(wv), lane = tid & 63, r = lane & 31, hh = lane >> 5, w = wv, map = w >> 2, qw = w & 3;
  const size_t rowbase = (size_t)bl * TB;
  bf16x8 qf[4];
  { const bf16_t* qp = Qb + (rowbase + q0 + qw * 32 + r) * 1024 + head * 128 + map * 64 + 8 * hh;
#pragma unroll
    for (int s = 0; s < 4; ++s) qf[s] = *(const bf16x8*)(qp + 16 * s); }
  const bf16_t* kg[2]; const bf16_t* vg[2]; unsigned kl[2], vl[2];
#pragma unroll
  for (int i = 0; i < 2; ++i) { const int c = tid + 512 * i;
    kg[i] = Kb + (rowbase + key0 + (c >> 4)) * 1024 + head * 128 + (c & 15) * 8; kl[i] = (unsigned)((c >> 4) * KSTR + (c & 15) * 16);
    vg[i] = Vt + (size_t)(bl * 1024 + head * 128 + (c >> 3)) * TB + key0 + (c & 7) * 8; vl[i] = (unsigned)(KBYTES + (c >> 3) * VSTR + (c & 7) * 16); }
  const int NT = nkeys >> 6;
  u32x4 kr[2], vr[2];
#define KSLOT(s) ((s) * KBYTES)
#define VSLOT(s) (3 * KBYTES + (s) * VBYTES)
#define ST_K(s) do { _Pragma("unroll") for (int i = 0; i < 2; ++i) *(LAS u32x4*)(lds + KSLOT(s) + kl[i]) = kr[i]; } while (0)
#define ST_V(s) do { _Pragma("unroll") for (int i = 0; i < 2; ++i) { *(LAS u32x2*)(lds + VSLOT(s) + vl[i]) = (u32x2){vr[i].x, vr[i].y}; *(LAS u32x2*)(lds + VSLOT(s) + vl[i] + 8) = (u32x2){vr[i].z, vr[i].w}; } } while (0)
#define LD_K(t) do { _Pragma("unroll") for (int i = 0; i < 2; ++i) kr[i] = *(const u32x4*)(kg[i] + (size_t)(t) * 64 * 1024); } while (0)
#define LD_V(t) do { _Pragma("unroll") for (int i = 0; i < 2; ++i) vr[i] = *(const u32x4*)(vg[i] + (t) * 64); } while (0)
#define QK(P0, P1, s) do { const LAS unsigned char* kb_ = lds + KSLOT(s) + r * KSTR + (map * 64 + 8 * hh) * 2; \
    _Pragma("unroll") for (int s_ = 0; s_ < 4; ++s_) { const bf16x8 a0 = *(const LAS bf16x8*)(kb_ + s_ * 32); const bf16x8 a1 = *(const LAS bf16x8*)(kb_ + 32 * KSTR + s_ * 32); \
      P0 = MFMA32(a0, qf[s_], P0); P1 = MFMA32(a1, qf[s_], P1); } } while (0)
  { u32x4 pk_[3][2], pv_[2][2];
#pragma unroll
    for (int t_ = 0; t_ < 3; ++t_)
#pragma unroll
      for (int i = 0; i < 2; ++i) { pk_[t_][i] = *(const u32x4*)(kg[i] + (size_t)t_ * 64 * 1024); if (t_ < 2) pv_[t_][i] = *(const u32x4*)(vg[i] + t_ * 64); }
#pragma unroll
    for (int t_ = 0; t_ < 3; ++t_)
#pragma unroll
      for (int i = 0; i < 2; ++i) { *(LAS u32x4*)(lds + KSLOT(t_) + kl[i]) = pk_[t_][i];
        if (t_ < 2) { *(LAS u32x2*)(lds + VSLOT(t_) + vl[i]) = (u32x2){pv_[t_][i].x, pv_[t_][i].y}; *(LAS u32x2*)(lds + VSLOT(t_) + vl[i] + 8) = (u32x2){pv_[t_][i].z, pv_[t_][i].w}; } } }
  __syncthreads();
  f32x16 o[4];
#pragma unroll
  for (int v = 0; v < 4; ++v)
#pragma unroll
    for (int i = 0; i < 16; ++i) o[v][i] = 0.f;
  float m_run, lsum = 0.f;
  f32x16 pA0, pA1, pB0, pB1;
  f32x16 zero16_;
#pragma unroll
  for (int i = 0; i < 16; ++i) zero16_[i] = 0.f;
#pragma unroll
  for (int i = 0; i < 16; ++i) { pA0[i] = 0.f; pA1[i] = 0.f; }
  QK(pA0, pA1, 0);
  { float mx = fmaxf(pA0[0], pA1[0]);
#pragma unroll
    for (int i = 1; i < 16; ++i) mx = fmaxf(mx, fmaxf(pA0[i], pA1[i]));
    mx = pl32_max(mx); m_run = __uint_as_float(cvt_pk_bf16(mx, 0.f) << 16);
#pragma unroll
    for (int i = 0; i < 16; ++i) { pA0[i] -= m_run; pA1[i] -= m_run; } }
  const u32x4 augA_ = {hh == 0 ? 0x3F80u : 0u, 0u, 0u, 0u};
#define SB() do {} while (0)
#define VFRAG(dst, sl, v) do { const LAS unsigned char* vb_ = lds + VSLOT(sl) + KBYTES + r * VSTR + (4 * hh) * 2 + (v) * 32 * VSTR; \
    _Pragma("unroll") for (int q_ = 0; q_ < 4; ++q_) { const u32x2 lo = *(const LAS u32x2*)(vb_ + q_ * 32), hi = *(const LAS u32x2*)(vb_ + q_ * 32 + 16); dst[q_] = (u32x4){lo.x, lo.y, hi.x, hi.y}; } } while (0)
#define BODY(PA0, PA1, PB0, PB1, t, HAS_NEXT, DO_BAR) do { \
    const int sl_ = (t) & 3; \
    bf16x8 kf_[4]; u32x4 vfa_[4], vfb_[4]; \
    const LAS unsigned char* kb_ = lds + KSLOT((sl_ + 1) & 3) + r * KSTR + (map * 64 + 8 * hh) * 2; \
    if ((t) + 3 < NT) LD_K((t) + 3); if ((t) + 2 < NT) LD_V((t) + 2); \
    if (HAS_NEXT) { \
      _Pragma("unroll") for (int s_ = 0; s_ < 4; ++s_) kf_[s_] = *(const LAS bf16x8*)(kb_ + s_ * 32); } \
    VFRAG(vfa_, sl_, 0); \
    SB(); \
    float ps_ = 0.f; \
    if (HAS_NEXT) { \
      const u32x4 augB_ = {hh == 0 ? (cvt_pk_bf16(-m_run, 0.f) & 0xffffu) : 0u, 0u, 0u, 0u}; \
      PB0 = MFMA32(__builtin_bit_cast(bf16x8, augA_), __builtin_bit_cast(bf16x8, augB_), zero16_); \
      PB1 = MFMA32(__builtin_bit_cast(bf16x8, augA_), __builtin_bit_cast(bf16x8, augB_), zero16_); \
      _Pragma("unroll") for (int s_ = 0; s_ < 4; ++s_) PB0 = MFMA32(kf_[s_], qf[s_], PB0); } \
    _Pragma("unroll") for (int i = 0; i < 16; ++i) { PA0[i] = __builtin_amdgcn_exp2f(PA0[i]); ps_ += PA0[i]; } \
    SB(); \
    if (HAS_NEXT) { \
      _Pragma("unroll") for (int s_ = 0; s_ < 4; ++s_) kf_[s_] = *(const LAS bf16x8*)(kb_ + 32 * KSTR + s_ * 32); \
      _Pragma("unroll") for (int s_ = 0; s_ < 4; ++s_) PB1 = MFMA32(kf_[s_], qf[s_], PB1); } \
    _Pragma("unroll") for (int i = 0; i < 16; ++i) { PA1[i] = __builtin_amdgcn_exp2f(PA1[i]); ps_ += PA1[i]; } \
    lsum += ps_; \
    bf16x8 pf_[4]; \
    _Pragma("unroll") for (int s2 = 0; s2 < 2; ++s2) { u32x4 a_, b_; \
      a_.x = cvt_pk_bf16(PA0[8 * s2 + 0], PA0[8 * s2 + 1]); a_.y = cvt_pk_bf16(PA0[8 * s2 + 2], PA0[8 * s2 + 3]); a_.z = cvt_pk_bf16(PA0[8 * s2 + 4], PA0[8 * s2 + 5]); a_.w = cvt_pk_bf16(PA0[8 * s2 + 6], PA0[8 * s2 + 7]); \
      b_.x = cvt_pk_bf16(PA1[8 * s2 + 0], PA1[8 * s2 + 1]); b_.y = cvt_pk_bf16(PA1[8 * s2 + 2], PA1[8 * s2 + 3]); b_.z = cvt_pk_bf16(PA1[8 * s2 + 4], PA1[8 * s2 + 5]); b_.w = cvt_pk_bf16(PA1[8 * s2 + 6], PA1[8 * s2 + 7]); \
      pf_[s2] = __builtin_bit_cast(bf16x8, a_); pf_[2 + s2] = __builtin_bit_cast(bf16x8, b_); } \
    SB(); \
    VFRAG(vfb_, sl_, 1); \
    _Pragma("unroll") for (int q_ = 0; q_ < 4; ++q_) o[0] = MFMA32(__builtin_bit_cast(bf16x8, vfa_[q_]), pf_[q_], o[0]); \
    SB(); \
    VFRAG(vfa_, sl_, 2); \
    _Pragma("unroll") for (int q_ = 0; q_ < 4; ++q_) o[1] = MFMA32(__builtin_bit_cast(bf16x8, vfb_[q_]), pf_[q_], o[1]); \
    SB(); \
    VFRAG(vfb_, sl_, 3); \
    _Pragma("unroll") for (int q_ = 0; q_ < 4; ++q_) o[2] = MFMA32(__builtin_bit_cast(bf16x8, vfa_[q_]), pf_[q_], o[2]); \
    float mx = 0.f; \
    if (HAS_NEXT) { mx = PB0[0]; \
      _Pragma("unroll") for (int i = 1; i < 16; ++i) mx = __builtin_fmaxf(mx, PB0[i]); \
      _Pragma("unroll") for (int i = 0; i < 16; ++i) mx = __builtin_fmaxf(mx, PB1[i]); } \
    SB(); \
    _Pragma("unroll") for (int q_ = 0; q_ < 4; ++q_) o[3] = MFMA32(__builtin_bit_cast(bf16x8, vfb_[q_]), pf_[q_], o[3]); \
    if (HAS_NEXT) { \
      mx = pl32_max(mx); \
      if (__any(mx > 8.0f)) { const float mn_ = __uint_as_float(cvt_pk_bf16(m_run + fmaxf(mx, 0.f), 0.f) << 16); const float dl = mn_ - m_run; m_run = mn_; const float al = __builtin_amdgcn_exp2f(-dl); lsum *= al; \
        _Pragma("unroll") for (int i = 0; i < 16; ++i) { PB0[i] -= dl; PB1[i] -= dl; } \
        _Pragma("unroll") for (int v = 0; v < 4; ++v) _Pragma("unroll") for (int i = 0; i < 16; ++i) o[v][i] *= al; } \
      } \
    if ((t) + 3 < NT) ST_K((sl_ + 3) & 3); if ((t) + 2 < NT) ST_V((sl_ + 2) & 3); \
    if (DO_BAR) __syncthreads(); } while (0)
  for (int t = 0; t < NT - 2; t += 2) { BODY(pA0, pA1, pB0, pB1, t, true, false); BODY(pB0, pB1, pA0, pA1, t + 1, true, true); }
  BODY(pA0, pA1, pB0, pB1, NT - 2, true, false); BODY(pB0, pB1, pA0, pA1, NT - 1, false, true);
#undef BODY
#undef VFRAG
#undef SB
#undef QK
#undef LD_K
#undef LD_V
#undef ST_K
#undef ST_V
#undef KSLOT
#undef VSLOT
  const float lam = __int_as_float(lam_bits), oml = 1.0f - __int_as_float(lami_bits);
  u32x4 zw_[4];
  { const bf16_t* zp_ = ZA + (rowbase + q0 + (tid >> 2)) * 1024 + head * 128 + (tid & 3) * 32;
#pragma unroll
    for (int j = 0; j < 4; ++j) zw_[j] = *(const u32x4*)(zp_ + j * 8); }
  const float ltot = pl32_sum(lsum); const float inv = 1.0f / ltot;
  LAS float* EX = (LAS float*)lds;
  if (map == 1) { const float sc = lam * inv;
#pragma unroll
    for (int v = 0; v < 4; ++v)
#pragma unroll
      for (int i = 0; i < 16; ++i) EX[(qw * 32 + r) * EXSTR + v * 32 + crow(i, hh)] = o[v][i] * sc; }
  __syncthreads();
  if (map == 0) { float ss = 0.f;
#pragma unroll
    for (int v = 0; v < 4; ++v)
#pragma unroll
      for (int i = 0; i < 16; ++i) { const float d = o[v][i] * inv - EX[(qw * 32 + r) * EXSTR + v * 32 + crow(i, hh)]; o[v][i] = d; ss += d * d; }
    ss = pl32_sum(ss);
    const float rstd = __builtin_amdgcn_rsqf(ss * (1.0f / 128.0f) + 1e-5f) * oml;
    LAS bf16_t* YT = (LAS bf16_t*)(lds + YT_OFF);
#pragma unroll
    for (int v = 0; v < 4; ++v)
#pragma unroll
      for (int i = 0; i < 16; ++i) { const int vd = v * 32 + crow(i, hh); const float y = o[v][i] * rstd * subw[vd]; YT[(qw * 32 + r) * (YTSTR / 2) + vd] = (bf16_t)(cvt_pk_bf16(y, 0.f) & 0xffffu); } }
  __syncthreads();
  { const int q = tid >> 2, seg = tid & 3; const size_t row = rowbase + q0 + q;
    bf16_t* op = ACAT + row * 3072 + head * 128 + seg * 32;
#pragma unroll
    for (int j = 0; j < 4; ++j) {
      const u32x4 yw = *(const LAS u32x4*)(lds + YT_OFF + q * YTSTR + seg * 64 + j * 16);
      const u32x4 zw = zw_[j]; const f32x4 z0 = {bf_lo(zw.x), bf_hi(zw.x), bf_lo(zw.y), bf_hi(zw.y)}, z1 = {bf_lo(zw.z), bf_hi(zw.z), bf_lo(zw.w), bf_hi(zw.w)};
      const f32x4 y0 = {bf_lo(yw.x), bf_hi(yw.x), bf_lo(yw.y), bf_hi(yw.y)}, y1 = {bf_lo(yw.z), bf_hi(yw.z), bf_lo(yw.w), bf_hi(yw.w)};
      st8(op + j * 8, y0 * z0, y1 * z1);
    } }
  __syncthreads();
}
}

__device__ __forceinline__ void norm_phase(int wv, const float* xlat, float* xctx, const float* px  , const float* pgate, const float* normw, const float* mod  , bf16_t* HN, bf16_t* SBL, bf16_t* SBC, int chunk, int r0 = 0, int r1 = RC, int wcu = -1, int ncu = 0) {
  const int tid_ = fresh_tid(wv), lane = tid_ & 63, gw = (wcu < 0 ? (int)blockIdx.x : wcu) * 8 + wv, NGW = (wcu < 0 ? (int)gridDim.x : ncu) * 8;
  for (int rr = r0 + gw; rr < r1; rr += NGW) {
    const int bl = rr / TB, j = rr % TB, b = chunk * CB + bl; const bool ctx = j >= SEQ;
    const float* xr = ctx ? (const float*)xctx + ((size_t)b * CTXL + (j - SEQ)) * 1024 : xlat + ((size_t)b * SEQ + j) * 1024;
    const float* md = mod + (size_t)(ctx ? 16 : b) * 3072;
    const int jc = ctx ? j - SEQ : j, nn = ctx ? CTXL : SEQ; const int sr = (jc == nn / 2) ? 0 : (jc > nn - 128 ? nn - jc : -1);
    bf16_t* sb = ctx ? SBC : SBL;
    f32x4 v[4]; float s = 0.f;
#pragma unroll
    for (int q = 0; q < 4; ++q) { v[q] = *(const f32x4*)(xr + 4 * lane + 256 * q);
      if (ctx && px) {
        const size_t po = ((size_t)bl * CTXL + (j - SEQ)) * 1024 + 4 * lane + 256 * q;
        const f32x4 pp = (*(const f32x4*)(px + po) + *(const f32x4*)(px + (size_t)2048 * 1024 + po)) + *(const f32x4*)(px + (size_t)2 * 2048 * 1024 + po);
        v[q] = v[q] + *(const f32x4*)(pgate + 4 * lane + 256 * q) * pp;
        *(f32x4*)(xctx + ((size_t)b * CTXL + (j - SEQ)) * 1024 + 4 * lane + 256 * q) = v[q]; }
      s += (v[q][0] * v[q][0] + v[q][1] * v[q][1]) + (v[q][2] * v[q][2] + v[q][3] * v[q][3]); }
    const float rstd = __builtin_amdgcn_rsqf(wave_sum(s, lane) * (1.0f / 1024.0f) + 1e-6f);
#pragma unroll
    for (int q = 0; q < 4; ++q) {
      const int c = 4 * lane + 256 * q;
      const f32x4 nw = *(const f32x4*)(normw + c), sh = *(const f32x4*)(md + c), sc = *(const f32x4*)(md + 1024 + c);
      const f32x4 y = (v[q] * rstd) * nw * (sc + 1.0f) + sh;
      u32x2 wv; wv.x = cvt_pk_bf16(y[0], y[1]); wv.y = cvt_pk_bf16(y[2], y[3]);
      *(u32x2*)(HN + (size_t)rr * 1024 + c) = wv;
      if (sr >= 0) *(u32x2*)(sb + ((size_t)bl * 128 + 127 - sr) * 1024 + c) = wv;
    }
  }
}
__device__ __forceinline__ void conv_phase(int wv, const bf16_t* U, const bf16_t* BZ, const float* cw  , bf16_t* ACAT) {
  const int tid_ = fresh_tid(wv), lane = tid_ & 63, gw = blockIdx.x * 8 + wv, NGW = gridDim.x * 8;
  for (int it = gw; it < (RC / 4) * 2; it += NGW) {
    const int q = it & 1, r0 = (it >> 1) * 4, j0 = r0 % TB, c = lane * 8 + 512 * q;
    const bool hp = !(j0 == 0 || j0 == SEQ), hn = !(j0 + 3 == SEQ - 1 || j0 + 3 == TB - 1);
    u32x4 uw[6], zw[4];
    uw[0] = hp ? *(const u32x4*)(U + (size_t)(r0 - 1) * 1024 + c) : (u32x4){0u, 0u, 0u, 0u};
#pragma unroll
    for (int k = 0; k < 4; ++k) { uw[1 + k] = *(const u32x4*)(U + (size_t)(r0 + k) * 1024 + c); zw[k] = *(const u32x4*)(BZ + (size_t)(r0 + k) * 1024 + c); }
    uw[5] = hn ? *(const u32x4*)(U + (size_t)(r0 + 4) * 1024 + c) : (u32x4){0u, 0u, 0u, 0u};
    const f32x4 w00 = *(const f32x4*)(cw + c), w01 = *(const f32x4*)(cw + c + 4), w10 = *(const f32x4*)(cw + 1024 + c), w11 = *(const f32x4*)(cw + 1024 + c + 4), w20 = *(const f32x4*)(cw + 2048 + c), w21 = *(const f32x4*)(cw + 2048 + c + 4);
#pragma unroll
    for (int k = 0; k < 4; ++k) {
      const u32x4 a = uw[k], b = uw[k + 1], d = uw[k + 2], z = zw[k];
      const f32x4 a0 = {bf_lo(a.x), bf_hi(a.x), bf_lo(a.y), bf_hi(a.y)}, a1 = {bf_lo(a.z), bf_hi(a.z), bf_lo(a.w), bf_hi(a.w)};
      const f32x4 b0 = {bf_lo(b.x), bf_hi(b.x), bf_lo(b.y), bf_hi(b.y)}, b1 = {bf_lo(b.z), bf_hi(b.z), bf_lo(b.w), bf_hi(b.w)};
      const f32x4 d0 = {bf_lo(d.x), bf_hi(d.x), bf_lo(d.y), bf_hi(d.y)}, d1 = {bf_lo(d.z), bf_hi(d.z), bf_lo(d.w), bf_hi(d.w)};
      const f32x4 z0 = {bf_lo(z.x), bf_hi(z.x), bf_lo(z.y), bf_hi(z.y)}, z1 = {bf_lo(z.z), bf_hi(z.z), bf_lo(z.w), bf_hi(z.w)};
      st8(ACAT + (size_t)(r0 + k) * 3072 + 1024 + c, (w00 * a0 + w10 * b0 + w20 * d0) * z0, (w01 * a1 + w11 * b1 + w21 * d1) * z1);
    }
  }
}
__device__ __forceinline__ void final_norm(int wv, float* x, const float* w) {
  const int tid_ = fresh_tid(wv), lane = tid_ & 63, gw = blockIdx.x * 8 + wv, NGW = gridDim.x * 8;
  for (int rr = gw; rr < NBATCH * SEQ; rr += NGW) {
    float* xr = x + (size_t)rr * 1024; f32x4 v[4]; float s = 0.f;
#pragma unroll
    for (int q = 0; q < 4; ++q) { v[q] = *(const f32x4*)(xr + 4 * lane + 256 * q); s += (v[q][0] * v[q][0] + v[q][1] * v[q][1]) + (v[q][2] * v[q][2] + v[q][3] * v[q][3]); }
    const float rstd = __builtin_amdgcn_rsqf(wave_sum(s, lane) * (1.0f / 1024.0f) + 1e-6f);
#pragma unroll
    for (int q = 0; q < 4; ++q) { const int c = 4 * lane + 256 * q; *(f32x4*)(xr + c) = (v[q] * rstd) * *(const f32x4*)(w + c); }
  }
}
__device__ __forceinline__ void transpose_item(const float* __restrict__ W, int ldw, bf16_t* dst, int ldo, LAS float* scr, int lane, bool rperm = false) {
#pragma unroll 8
  for (int i = 0; i < 32; ++i) { const int kk = 2 * i + (lane >> 5); scr[kk * 33 + (lane & 31)] = W[(size_t)kk * ldw + (lane & 31)]; }
  asm volatile("s_waitcnt lgkmcnt(0)" ::: "memory");
  const int c = lane & 7;
#pragma unroll
  for (int j = 0; j < 4; ++j) { const int n = (lane >> 3) + 8 * j; const LAS float* s = scr + (8 * c) * 33 + n;
    const int nd = rperm ? (((n & 15) >> 2) * 8 + ((n >> 4) << 2) + (n & 3)) : n;
    u32x4 o; o.x = cvt_pk_bf16(s[0 * 33], s[1 * 33]); o.y = cvt_pk_bf16(s[2 * 33], s[3 * 33]); o.z = cvt_pk_bf16(s[4 * 33], s[5 * 33]); o.w = cvt_pk_bf16(s[6 * 33], s[7 * 33]);
    *(u32x4*)(dst + (size_t)nd * ldo + 8 * c) = o; }
  asm volatile("s_waitcnt lgkmcnt(0)" ::: "memory");
}
__device__ __forceinline__ int win_dest_row(int n0) {
  const int seg = n0 >> 10, off = n0 & 1023;
  switch (seg) {
    case 0: return off;
    case 1: return 1024 + off;
    case 2: return -1 - off;
    case 3: return 2048 + off;
    case 4: return 3072 + (off >> 7) * 256 + (off & 127);
    case 6: return 3072 + (off >> 7) * 256 + 128 + (off & 127);
    case 5: return 5120 + (off >> 7) * 256 + (off & 127);
    case 7: return 5120 + (off >> 7) * 256 + 128 + (off & 127);
    case 8: return -100000;
    case 9: return 7168 + off;
    default: return 8192 + (n0 - 10240);
  }
}

#define WS_PTRS(w_) \
  float* MOD = (float*)((w_) + WS_MOD); float* ROPEC = (float*)((w_) + WS_ROPEC); float* ROPES = (float*)((w_) + WS_ROPES); float* LAM = (float*)((w_) + WS_LAM); \
  float* XC = (float*)((w_) + WS_XC); bf16_t* DFT = (bf16_t*)((w_) + WS_DFT); bf16_t* DFTC = (bf16_t*)((w_) + WS_DFTC); \
  bf16_t* HN = (bf16_t*)((w_) + WS_HN); bf16_t* QB = (bf16_t*)((w_) + WS_QB); bf16_t* KB = (bf16_t*)((w_) + WS_KB); bf16_t* ZA = (bf16_t*)((w_) + WS_ZA); \
  bf16_t* U = (bf16_t*)((w_) + WS_U); bf16_t* BZ = (bf16_t*)((w_) + WS_BZ); bf16_t* ZF = (bf16_t*)((w_) + WS_ZF); bf16_t* VT = (bf16_t*)((w_) + WS_VT); \
  bf16_t* YG = (bf16_t*)((w_) + WS_YG); bf16_t* GT = (bf16_t*)((w_) + WS_GT); bf16_t* HT = (bf16_t*)((w_) + WS_HT); bf16_t* HTC = (bf16_t*)((w_) + WS_HTC); bf16_t* ACAT = (bf16_t*)((w_) + WS_ACAT); \
  (void)0

struct Args { const float* in[16]; float* out; unsigned char* ws; float lam_init[4]; int pad[2]; };

__global__ void __launch_bounds__(512, 2) fwd_megakernel(Args args) {
  extern __shared__ __attribute__((aligned(16))) unsigned char lds_raw[];
  LAS unsigned char* lds = (LAS unsigned char*)lds_raw;
  cg::grid_group grid = cg::this_grid();
  const int G = gridDim.x, bx = blockIdx.x;
  const int wv = __builtin_amdgcn_readfirstlane((int)(threadIdx.x >> 6));
  volatile LAS unsigned* bst = (volatile LAS unsigned*)(lds + 147456 - 128);
  if (threadIdx.x < 2) bst[threadIdx.x] = 0u;
  __syncthreads();
  XcdBarrier xbar; xbar.bar = (unsigned*)(args.ws + WS_BAR); xbar.x = xb_xcc_id(); xbar.st = bst;
  if (blockIdx.x == 0) { for (int i_ = threadIdx.x; i_ < XCD_BAR_WORDS; i_ += 512) xbar.bar[i_] = 0u; }
  unsigned char* ws = args.ws; float* OUT = args.out;
  const float* x_in = args.in[0]; const float* c_in = args.in[1]; const float* ctx_in = args.in[2]; const float* cctx_in = args.in[3];
  const float* norm_w = args.in[4]; const float* w_mod = args.in[5]; const float* b_mod = args.in[6]; const float* w_in = args.in[7];
  const float* lambda_qk = args.in[8]; const float* subln_w = args.in[9]; const float* conv_w = args.in[10];
  const float* w_ao = args.in[11]; const float* w_co = args.in[12]; const float* w_fo = args.in[13]; const float* w_out = args.in[14]; const float* final_w = args.in[15];

  {
  WS_PTRS(ws);
  const int tid = fresh_tid(wv), lane = tid & 63, wave = wv, gw = bx * 8 + wave, NGW = G * 8;
  {
    LAS float* scr = (LAS float*)(lds + wave * 8448);
    constexpr int I_IN = 16 * 416, I_SQ = 16 * 32, PER_L = I_IN + 4 * I_SQ;
    for (int it = gw; it < DEPTH * PER_L; it += NGW) {
      const int l = it / PER_L; int r = it % PER_L;
      unsigned char* wl = ws + WS_W + (size_t)l * W_LAYER;
      if (r < I_IN) {
        const int kb = r / 416, nb = r % 416, n0 = nb * 32, k0 = kb * 64; const int dr = win_dest_row(n0);
        if (dr == -100000) continue;
        bf16_t* dst = dr >= 0 ? (bf16_t*)(wl + W_T1) + (size_t)dr * 1024 + k0 : (bf16_t*)(wl + W_T2) + (size_t)(-1 - dr) * 1024 + k0;
        transpose_item(w_in + ((size_t)l * 1024 + k0) * PROJW + n0, PROJW, dst, 1024, scr, lane, n0 < 2048);
      } else {
        r -= I_IN; const int mi = r / I_SQ, q = r % I_SQ, kb = q / 32, nb = q % 32, n0 = nb * 32, k0 = kb * 64;
        const float* src = (mi == 0 ? w_ao : mi == 1 ? w_co : mi == 2 ? w_fo : w_out) + ((size_t)l * 1024 + k0) * 1024 + n0;
        if (mi < 3) transpose_item(src, 1024, (bf16_t*)(wl + W_CAT) + (size_t)(mi * 1024 + n0) * 1024 + k0, 1024, scr, lane);
        else {
#pragma unroll 1
          for (int rep = 0; rep < 3; ++rep) transpose_item(src, 1024, (bf16_t*)(wl + W_O3) + (size_t)n0 * 3072 + rep * 1024 + k0, 3072, scr, lane);
        }
      }
    }
  }
  __syncthreads();
  {
    LAS float* Wl = (LAS float*)lds; LAS float* tabc = (LAS float*)(lds + 64 * 132 * 4); LAS float* tabs = tabc + 128;
    for (int item = bx; item < 512; item += G) {
      const int l = item >> 7, g = (item >> 4) & 7, kb = item & 15;
      const float* W = w_in + ((size_t)l * 1024 + kb * 64) * PROJW + 8192 + g * 128;
      __syncthreads();
#pragma unroll
      for (int i = 0; i < 4; ++i) { const int idx = tid + 512 * i, row = idx >> 5, c4 = idx & 31; *(LAS f32x4*)(Wl + row * 132 + c4 * 4) = *(const f32x4*)(W + (size_t)row * PROJW + c4 * 4); }
      if (tid < 128) { const float ph = (float)tid * (1.0f / 128.0f); tabc[tid] = __builtin_amdgcn_cosf(ph) * 0.08838834764831845f; tabs[tid] = __builtin_amdgcn_sinf(ph) * 0.08838834764831845f; }
      __syncthreads();
      const int s = tid >> 2, kq = tid & 3, part = s > 64, k2 = part ? s - 64 : s;
      const LAS float* tab = part ? tabs : tabc;
      float acc[16];
#pragma unroll
      for (int k = 0; k < 16; ++k) acc[k] = 0.f;
#pragma unroll 1
      for (int j4 = 0; j4 < 32; ++j4) {
        const float c0 = tab[((4 * j4 + 0) * k2) & 127], c1 = tab[((4 * j4 + 1) * k2) & 127], c2 = tab[((4 * j4 + 2) * k2) & 127], c3 = tab[((4 * j4 + 3) * k2) & 127];
#pragma unroll
        for (int k = 0; k < 16; ++k) { const f32x4 w4 = *(const LAS f32x4*)(Wl + (kq * 16 + k) * 132 + 4 * j4); acc[k] += (w4[0] * c0 + w4[1] * c1) + (w4[2] * c2 + w4[3] * c3); }
      }
      bf16_t* dst = (bf16_t*)(ws + WS_W + (size_t)l * W_LAYER + W_T2) + (size_t)(1024 + g * 128 + s) * 1024 + kb * 64 + kq * 16;
#pragma unroll
      for (int q = 0; q < 2; ++q) { u32x4 o; o.x = cvt_pk_bf16(acc[8 * q + 0], acc[8 * q + 1]); o.y = cvt_pk_bf16(acc[8 * q + 2], acc[8 * q + 3]); o.z = cvt_pk_bf16(acc[8 * q + 4], acc[8 * q + 5]); o.w = cvt_pk_bf16(acc[8 * q + 6], acc[8 * q + 7]); *(u32x4*)(dst + 8 * q) = o; }
    }
  }
  __syncthreads();
  {
    const int gt = bx * 512 + tid, NGT = G * 512;
    for (int item = gt; item < 2048 * 256; item += NGT) {
      const int k1 = item >> 8, j0 = (item & 255) * 8; float v[8];
#pragma unroll
      for (int e = 0; e < 8; ++e) { const int j = j0 + e; const bool sn = j >= 1024; const float ph = (float)((k1 * (j & 1023)) & 2047) * (1.0f / 2048.0f);
        v[e] = (sn ? -__builtin_amdgcn_sinf(ph) : __builtin_amdgcn_cosf(ph)) * 0.022097086912079608f; }
      u32x4 o; o.x = cvt_pk_bf16(v[0], v[1]); o.y = cvt_pk_bf16(v[2], v[3]); o.z = cvt_pk_bf16(v[4], v[5]); o.w = cvt_pk_bf16(v[6], v[7]);
      *(u32x4*)(DFT + (size_t)k1 * 2048 + j0) = o;
    }
    for (int item = gt; item < 256 * 32; item += NGT) {
      const int k1 = item >> 5, j0 = (item & 31) * 8; float v[8];
#pragma unroll
      for (int e = 0; e < 8; ++e) { const int j = j0 + e; const bool sn = j >= 128; const float ph = (float)((k1 * (j & 127)) & 255) * (1.0f / 256.0f);
        v[e] = (sn ? -__builtin_amdgcn_sinf(ph) : __builtin_amdgcn_cosf(ph)) * 0.0625f; }
      u32x4 o; o.x = cvt_pk_bf16(v[0], v[1]); o.y = cvt_pk_bf16(v[2], v[3]); o.z = cvt_pk_bf16(v[4], v[5]); o.w = cvt_pk_bf16(v[6], v[7]);
      *(u32x4*)(DFTC + (size_t)k1 * 256 + j0) = o;
    }
    for (int item = gt; item < NBATCH * CTXL * 256; item += NGT) *(f32x4*)(XC + (size_t)item * 4) = *(const f32x4*)(ctx_in + (size_t)item * 4);
    if (gt < 1024) { const int p = gt >> 4, i = gt & 15; const float inv = __builtin_amdgcn_exp2f(-(float)i * (13.287712379549449f / 16.0f)); const float a = (float)p * inv;
      ROPEC[gt] = __builtin_amdgcn_cosf(a * 0.15915494309189535f); ROPES[gt] = __builtin_amdgcn_sinf(a * 0.15915494309189535f); }
    if (gt < DEPTH) { const float* lq = lambda_qk + gt * 256; float s1 = 0.f, s2 = 0.f;
      for (int i = 0; i < 64; ++i) { s1 += lq[i] * lq[64 + i]; s2 += lq[128 + i] * lq[192 + i]; }
      LAM[gt] = __builtin_amdgcn_exp2f(s1 * LOG2E) - __builtin_amdgcn_exp2f(s2 * LOG2E) + args.lam_init[gt]; }
  }
  {
    LAS float* sl = (LAS float*)lds; LAS float* red = (LAS float*)(lds + 17 * 1024 * 4);
    if (bx < 192) {
      for (int idx = tid; idx < 17 * 1024; idx += 512) { const int r = idx >> 10, k = idx & 1023; const float xv = (r < 16) ? c_in[r * 1024 + k] : cctx_in[k]; sl[idx] = xv * fast_sigmoid(xv); }
      __syncthreads();
      for (int item = bx; item < 192; item += G) {
        const int l = item / 48, cb = item % 48, cc = tid & 63, ks = tid >> 6;
        float acc[17];
#pragma unroll
        for (int r = 0; r < 17; ++r) acc[r] = 0.f;
        const float* wp = w_mod + ((size_t)l * 1024 + ks * 128) * 3072 + cb * 64 + cc;
#pragma unroll 4
        for (int k = 0; k < 128; ++k) { const float wv = wp[(size_t)k * 3072];
#pragma unroll
          for (int r = 0; r < 17; ++r) acc[r] += sl[r * 1024 + ks * 128 + k] * wv; }
#pragma unroll
        for (int r = 0; r < 17; ++r) red[(ks * 17 + r) * 64 + cc] = acc[r];
        __syncthreads();
        for (int idx = tid; idx < 17 * 64; idx += 512) { const int r = idx >> 6, c2 = idx & 63; float s = 0.f;
#pragma unroll
          for (int k8 = 0; k8 < 8; ++k8) s += red[(k8 * 17 + r) * 64 + c2];
          MOD[((size_t)l * 17 + r) * 3072 + cb * 64 + c2] = s + b_mod[l * 3072 + cb * 64 + c2]; }
        __syncthreads();
      }
    }
  }
  }
  grid.sync();
  if (threadIdx.x == 0) (void)xb_add(&xbar.bar[XB_XCNT(xbar.x)], 1u);
  { unsigned char* w_ = fresh_ptr(ws); WS_PTRS(w_); norm_phase(wv, x_in, XC, nullptr, nullptr, norm_w, MOD, HN, (bf16_t*)(w_ + WS_SBL), (bf16_t*)(w_ + WS_SBC), 0); }
  xcd_barrier(xbar, wv);

#pragma unroll 1
  for (int step = 0; step < DEPTH * NCH; ++step) {
    const int l = step >> 1, ch = step & 1;
    int bxl = blockIdx.x, Gl = gridDim.x; asm volatile("" : "+s"(bxl), "+s"(Gl));
    { unsigned char* w_ = fresh_ptr(ws); WS_PTRS(w_); unsigned char* wl = w_ + WS_W + (size_t)l * W_LAYER;
      pg8::Gemm g{1024, 1024, 1024};
      const int lastl = (l == DEPTH - 1);
      PlainOrder S; S.init2(HN, wl + W_T1, lastl ? CB * SEQ : RC, N1, 1024, 1024, Gl, bxl, 1 << 30, 0, lastl ? 2 : 0);
      EpiMain E{QB, KB, ZA, U, BZ, ZF, GT, ROPEC, ROPES};
      pg8::gemm_phase<EpiMain, PlainOrder>(wv, lds, g, S, E);
      PlainOrder S2; S2.init2(wl + W_T2, HN, 1024, RC, 1024, 1024, Gl, (bxl + Gl - 96) % Gl);
      EpiT E2{VT, HT, HTC};
      pg8::gemm_phase<EpiT, PlainOrder>(wv, lds, g, S2, E2);
      MirrorOrder S3{Gl, (bxl + Gl - 128) % Gl, (const char*)(wl + W_T2), (const char*)HN, (const char*)(w_ + WS_SBL), (const char*)(w_ + WS_SBC)};
      EpiT2 E3{HT, HTC, (float*)(w_ + WS_NYQ), (float*)(w_ + WS_NYQC)};
      pg8::gemm_phase<EpiT2, MirrorOrder>(wv, lds, g, S3, E3);
      if (step > 0)
      { const int lp_ = ((step - 1) >> 1), chp_ = ((step - 1) & 1); unsigned char* wlp = w_ + WS_W + (size_t)lp_ * W_LAYER;
        pg8::Gemm g5{1024, 3072, 1024};
        PlainOrder S5; S5.init2(w_ + WS_MRG, wlp + W_O3, CB * SEQ, 1024, 1024, 3072, Gl, (bxl + Gl - 160) % Gl, 1 << 30, 0, 1);
        EpiRes E5{lp_ == 0 ? x_in : OUT, XC, OUT, XC, MOD + (size_t)lp_ * 17 * 3072, chp_};
        pg8::gemm_phase<EpiRes, PlainOrder>(wv, lds, g5, S5, E5);
        if (lp_ < DEPTH - 1) {
          pg8::Gemm gc{3072, 3072, 1024};
          CtxOrder SC{Gl, (bxl + Gl - 160) % Gl, (const char*)(w_ + WS_YGC), (const char*)(wlp + W_O3), (size_t)256 * 3072 * 2, (size_t)256 * 3072 * 2, 1, 0};
          EpiPart EC{(float*)(w_ + WS_PX) + (size_t)chp_ * 3 * 2048 * 1024};
          pg8::gemm_phase<EpiPart, CtxOrder>(wv, lds, gc, SC, EC); } }
    }
    xcd_barrier(xbar, wv);
    { unsigned char* w_ = fresh_ptr(ws); WS_PTRS(w_); const int lam = __builtin_amdgcn_readfirstlane(__float_as_int(LAM[l])), oml = __builtin_amdgcn_readfirstlane(__float_as_int(args.lam_init[l]));
      const float* subw = subln_w + l * 128;
      for (int i_ = 0;; ++i_) { int bh, qb; int G_ = Gl; asm volatile("" : "+s"(G_));
        if (G_ == 256) { if (i_ >= (CB * NHEAD * 16) / 256) break; const int xj_ = bxl >> 3; bh = i_ * 16 + (bxl & 7) * 2 + (xj_ >> 4); qb = xj_ & 15; }
        else { const int uidx = i_ * Gl + bxl; if (uidx >= CB * NHEAD * 16) break; bh = uidx >> 4; qb = uidx & 15; }
        att::attn_unit(wv, lds, QB, KB, VT, ZA, ACAT, bh >> 3, bh & 7, qb * 128, 0, TB, lam, oml, subw); }
      if (l < DEPTH - 1) for (int uidx = bxl; uidx < CB * NHEAD * 2; uidx += Gl) { const int bh = uidx >> 1, qb = uidx & 1;
        att::attn_unit(wv, lds, QB, KB, VT, ZA, ACAT, bh >> 3, bh & 7, SEQ + qb * 128, SEQ, CTXL, lam, oml, subw); }
      EpiFour EF{ACAT, ZF, (const float*)(w_ + WS_NYQ), (const float*)(w_ + WS_NYQC)};
      { pg8::Gemm g{2048, 2048, 2048}; BatchOrder S{CB, 8, 4, Gl, (bxl + Gl - 128) % Gl, 0, (const char*)DFT, (const char*)HT, (size_t)256 * 2048 * 2, (size_t)1024 * 2048 * 2, (size_t)256 * 2048 * 2};
        pg8::gemm_phase<EpiFour, BatchOrder>(wv, lds, g, S, EF); }
      if (l < DEPTH - 1) { pg8::Gemm g{256, 256, 256}; BatchOrder S{CB, 1, 4, Gl, (bxl + Gl - 128) % Gl, 8, (const char*)DFTC, (const char*)HTC, 0, (size_t)1024 * 256 * 2, (size_t)256 * 256 * 2};
        pg8::gemm_phase<EpiFour, BatchOrder>(wv, lds, g, S, EF); }
      conv_phase(wv, U, BZ, conv_w + l * 3072, ACAT); }
    xcd_barrier(xbar, wv);
    { unsigned char* w_ = fresh_ptr(ws); WS_PTRS(w_); unsigned char* wl = w_ + WS_W + (size_t)l * W_LAYER;
      pg8::Gemm g{3072, 1024, 1024};
      const int lastl = (l == DEPTH - 1);
      TripleOrder S; S.so.init(ACAT, wl + W_CAT, CB * SEQ, 1024, 3072, 1024, Gl, bxl); S.W = (const char*)(wl + W_CAT); S.lat = 1;
      EpiAcc E{(bf16_t*)(w_ + WS_MRG), GT, (float*)(w_ + WS_SCR) + (size_t)bxl * 65536};
      pg8::gemm_phase<EpiAcc, TripleOrder>(wv, lds, g, S, E);
      if (!lastl) {
        CtxOrder SC{Gl, bxl, (const char*)ACAT, (const char*)(wl + W_CAT), (size_t)256 * 3072 * 2, (size_t)256 * 1024 * 2, 0, 1};
        EpiMulBf16 EC{(bf16_t*)(w_ + WS_YGC), GT, 3072, 3072, 0, 0, 1};
        pg8::gemm_phase<EpiMulBf16, CtxOrder>(wv, lds, g, SC, EC);
      }
      if (step + 1 < DEPTH * NCH) {
        const int l2 = (step + 1) >> 1, ch2 = (step + 1) & 1;
        const float* px2 = l2 == 0 ? nullptr : (const float*)(w_ + WS_PX) + (size_t)ch2 * 3 * 2048 * 1024; const float* pg2 = l2 == 0 ? nullptr : MOD + (size_t)(l2 - 1) * 17 * 3072 + 16 * 3072 + 2048;
        if (Gl == 256 && !lastl) { if (bxl >= 96) norm_phase(wv, l2 == 0 ? x_in : OUT, XC, px2, pg2, norm_w + l2 * 1024, MOD + (size_t)l2 * 17 * 3072, HN, (bf16_t*)(w_ + WS_SBL), (bf16_t*)(w_ + WS_SBC), ch2, 0, RC, bxl - 96, 160); }
        else norm_phase(wv, l2 == 0 ? x_in : OUT, XC, px2, pg2, norm_w + l2 * 1024, MOD + (size_t)l2 * 17 * 3072, HN, (bf16_t*)(w_ + WS_SBL), (bf16_t*)(w_ + WS_SBC), ch2); } }
    xcd_barrier(xbar, wv);
  }
  { unsigned char* w_ = fresh_ptr(ws); WS_PTRS(w_); int bxl = blockIdx.x, Gl = gridDim.x; asm volatile("" : "+s"(bxl), "+s"(Gl));
      { const int lp_ = (DEPTH - 1), chp_ = (NCH - 1); unsigned char* wlp = w_ + WS_W + (size_t)lp_ * W_LAYER;
        pg8::Gemm g5{1024, 3072, 1024};
        PlainOrder S5; S5.init2(w_ + WS_MRG, wlp + W_O3, CB * SEQ, 1024, 1024, 3072, Gl, (bxl + Gl - 160) % Gl, 1 << 30, 0, 1);
        EpiRes E5{lp_ == 0 ? x_in : OUT, XC, OUT, XC, MOD + (size_t)lp_ * 17 * 3072, chp_};
        pg8::gemm_phase<EpiRes, PlainOrder>(wv, lds, g5, S5, E5);
        if (lp_ < DEPTH - 1) {
          pg8::Gemm gc{3072, 3072, 1024};
          CtxOrder SC{Gl, (bxl + Gl - 160) % Gl, (const char*)(w_ + WS_YGC), (const char*)(wlp + W_O3), (size_t)256 * 3072 * 2, (size_t)256 * 3072 * 2, 1, 0};
          EpiPart EC{(float*)(w_ + WS_PX) + (size_t)chp_ * 3 * 2048 * 1024};
          pg8::gemm_phase<EpiPart, CtxOrder>(wv, lds, gc, SC, EC); } }
  }
  xcd_barrier(xbar, wv);
  final_norm(wv, args.out, final_w);
}

extern "C" void kernel_launch(void* const* d_in, const int* in_sizes, int n_in, void* d_out, int out_size, void* d_ws, size_t ws_size, hipStream_t stream) {
  static int grid = 0;
  constexpr int LDS_BYTES = 147456;
  if (grid == 0) {
    if (n_in != 16 || out_size != NBATCH * SEQ * D || ws_size < WS_END) { fprintf(stderr, "kernel_launch: unexpected shapes / workspace (%d inputs, out %d, ws %zu)\n", n_in, out_size, ws_size); grid = -1; return; }
    int dev = 0, cus = 0, per_cu = 0;
    (void)hipGetDevice(&dev); (void)hipDeviceGetAttribute(&cus, hipDeviceAttributeMultiprocessorCount, dev);
    (void)hipFuncSetAttribute((const void*)fwd_megakernel, hipFuncAttributeMaxDynamicSharedMemorySize, LDS_BYTES);
    (void)hipOccupancyMaxActiveBlocksPerMultiprocessor(&per_cu, (const void*)fwd_megakernel, 512, LDS_BYTES);
    if (per_cu < 1) { fprintf(stderr, "kernel_launch: occupancy query says %d blocks per CU\n", per_cu); per_cu = 1; }
    grid = cus;
    if (grid % 8 != 0 || grid < 200) fprintf(stderr, "kernel_launch: unexpected CU count %d\n", cus);
  }
  if (grid < 0) return;
  Args a{};
  for (int i = 0; i < 16; ++i) a.in[i] = (const float*)d_in[i];
  a.out = (float*)d_out; a.ws = (unsigned char*)d_ws;
  const double li[4] = {0.8 - 0.6 * 1.0, 0.8 - 0.6 * 0.7408182206817179, 0.8 - 0.6 * 0.5488116360940264, 0.8 - 0.6 * 0.4065696597405991};
  for (int i = 0; i < 4; ++i) a.lam_init[i] = (float)li[i];
  void* kargs[] = {&a};
  hipError_t e = hipLaunchCooperativeKernel((void*)fwd_megakernel, dim3(grid), dim3(512), kargs, LDS_BYTES, stream);
  if (e != hipSuccess) fprintf(stderr, "kernel_launch: cooperative launch failed: %s (grid %d)\n", hipGetErrorString(e), grid);
}
```

```cpp
#include <hip/hip_runtime.h>
#include <hip/hip_cooperative_groups.h>
#include <cstdio>
#include <cstdint>
namespace cg = cooperative_groups;

#define LAS __attribute__((address_space(3)))
typedef unsigned short bf16_t;
typedef short bf16x8 __attribute__((ext_vector_type(8)));
typedef float f32x4 __attribute__((ext_vector_type(4)));
typedef float f32x2 __attribute__((ext_vector_type(2)));
typedef float f32x16 __attribute__((ext_vector_type(16)));
typedef unsigned u32x4 __attribute__((ext_vector_type(4)));
typedef unsigned u32x2 __attribute__((ext_vector_type(2)));
typedef __bf16 bf16x2_t __attribute__((ext_vector_type(2)));

constexpr int D = 1024, NBATCH = 16, SEQ = 2048, CTXL = 256, TB = SEQ + CTXL  , DEPTH = 4;
constexpr int NCH = 2, CB = NBATCH / NCH  , RC = CB * TB  ;
constexpr int N1 = 11264, N2 = 2048, PROJW = 13312;
constexpr int NHEAD = 8;
constexpr float QSCALE = 0.125f * 1.4426950408889634f;
constexpr float LOG2E = 1.4426950408889634f;

constexpr size_t MiB = 1u << 20;
constexpr size_t WS_MOD = 0;
constexpr size_t WS_ROPEC = 835584, WS_ROPES = WS_ROPEC + 4096, WS_LAM = WS_ROPES + 4096;
constexpr size_t WS_NYQ = 828 * 1024, WS_NYQC = 860 * 1024;
constexpr size_t WS_BAR = 896 * 1024, BAR_BYTES = 16384;
constexpr size_t WS_XC = 1 * MiB;
constexpr size_t WS_DFT = 17 * MiB;
constexpr size_t WS_DFTC = 33 * MiB;
constexpr size_t WS_W = 34 * MiB;
constexpr size_t W_LAYER = 40 * MiB, W_T1 = 0, W_T2 = (size_t)N1 * 1024 * 2, W_CAT = W_T2 + 6 * MiB, W_O3 = W_CAT + 6 * MiB;
constexpr size_t WS_SBL = WS_W + W_T2 + 4 * MiB, WS_SBC = WS_W + W_LAYER + W_T2 + 4 * MiB;
constexpr size_t WS_HN = 194 * MiB, WS_QB = 230 * MiB, WS_KB = 266 * MiB, WS_ZA = 302 * MiB, WS_U = 338 * MiB, WS_BZ = 374 * MiB, WS_ZF = 410 * MiB, WS_VT = 446 * MiB;
constexpr size_t WS_YG = WS_QB;
constexpr size_t WS_MRG = 626 * MiB;
constexpr size_t WS_SCR = WS_KB;
constexpr size_t WS_GT = 482 * MiB;
constexpr size_t WS_HT = 590 * MiB;
constexpr size_t WS_HTC = 622 * MiB;
constexpr size_t WS_ACAT = 662 * MiB;
constexpr size_t WS_YGC = 770 * MiB;
constexpr size_t WS_PX = 782 * MiB;
constexpr size_t WS_END = 830 * MiB;
static_assert(W_O3 + 6 * MiB == W_LAYER, "weights");

__device__ __forceinline__ int fresh_tid(int wv) {
  int t = (wv << 6) | (int)__builtin_amdgcn_mbcnt_hi(~0u, __builtin_amdgcn_mbcnt_lo(~0u, 0u)); asm volatile("" : "+v"(t)); return t; }
template <class T> __device__ __forceinline__ T* fresh_ptr(T* p) { __attribute__((address_space(1))) T* g = (__attribute__((address_space(1))) T*)p; asm volatile("" : "+s"(g)); return (T*)g; }
__device__ __forceinline__ unsigned cvt_pk_bf16(float lo, float hi) { f32x2 v = {lo, hi}; bf16x2_t b = __builtin_convertvector(v, bf16x2_t); return __builtin_bit_cast(unsigned, b); }
__device__ __forceinline__ float bf_lo(unsigned w) { return __uint_as_float(w << 16); }
__device__ __forceinline__ float bf_hi(unsigned w) { return __uint_as_float(w & 0xffff0000u); }
__device__ __forceinline__ float fast_sigmoid(float x) { return __builtin_amdgcn_rcpf(1.0f + __builtin_amdgcn_exp2f(-x * LOG2E)); }
__device__ __forceinline__ float fast_silu(float x) { return x * fast_sigmoid(x); }
__device__ __forceinline__ float pl32_sum(float v) { auto rr = __builtin_amdgcn_permlane32_swap(__float_as_uint(v), __float_as_uint(v), false, false); return __uint_as_float(rr[0]) + __uint_as_float(rr[1]); }
__device__ __forceinline__ float pl32_max(float v) { auto rr = __builtin_amdgcn_permlane32_swap(__float_as_uint(v), __float_as_uint(v), false, false); return __builtin_fmaxf(__uint_as_float(rr[0]), __uint_as_float(rr[1])); }
__device__ __forceinline__ float pl32_other(float v, int hi) { auto rr = __builtin_amdgcn_permlane32_swap(__float_as_uint(v), __float_as_uint(v), false, false); return __uint_as_float(hi ? rr[0] : rr[1]); }
__device__ __forceinline__ float wave_sum(float v, int lane) {
#pragma unroll
  for (int o = 1; o < 32; o <<= 1) v += __int_as_float(__builtin_amdgcn_ds_bpermute((lane ^ o) << 2, __float_as_int(v)));
  return pl32_sum(v);
}

namespace pg8 {
constexpr int BM = 256, BK = 64, HALF = 128, HTB = HALF * BK * 2, STAGE_BYTES = 8 * HTB, NXCD = 8, WGM = 8;
__host__ __device__ __forceinline__ int lds_byte(int r, int c) { const int st = (r >> 4) * 2 + (c >> 5), rr = r & 15, cc = c & 31, ob = rr * 64 + cc * 2; return st * 1024 + (ob ^ (((ob >> 9) & 1) << 5)); }
__host__ __device__ __forceinline__ void stage_rc(int b, int& R, int& C) { const int st = b / 1024, sb = b % 1024, swz = sb ^ (((sb >> 9) & 1) << 5); R = (st >> 1) * 16 + swz / 64; C = (st & 1) * 32 + (swz % 64) / 2; }
__host__ __device__ __forceinline__ int perm32(int rho) { const int n = rho >> 4, i = rho & 15; return 8 * (i >> 2) + 4 * n + (i & 3); }

struct Unit { int pm, pn; const char* a; const char* b; const char* b2; };
struct Gemm { int lda, ldb, K; };

struct StaticOrder {
  int nM, nN, nwg, G, c; const char* A; const char* B; size_t ta, tb;
  __device__ void init(const void* A_, const void* B_, int M, int N, int lda, int ldb, int G_, int c_) { nM = M / BM; nN = N / BM; nwg = nM * nN; G = G_; c = c_; A = (const char*)A_; B = (const char*)B_; ta = (size_t)BM * lda * 2; tb = (size_t)BM * ldb * 2; }
  __device__ bool next(int i, Unit& u) const {
    const long L = (long)i * G + c; if (L >= nwg) return false;
    int wgid = (int)L; { const int q = nwg / NXCD, r = nwg % NXCD, xcd = wgid % NXCD, off = wgid / NXCD; wgid = (xcd < r ? xcd * (q + 1) : r * (q + 1) + (xcd - r) * q) + off; }
    const int nig = WGM * nN, gid = wgid / nig, fm = gid * WGM, gsz = (nM - fm) < WGM ? (nM - fm) : WGM;
    u.pm = fm + ((wgid % nig) % gsz); u.pn = (wgid % nig) / gsz; u.a = A + (size_t)u.pm * ta; u.b = B + (size_t)u.pn * tb; return true;
  }
};

template <class Epi, class Sched, bool ALIGN_EPI = true, bool SP2 = true>
__device__ __forceinline__ void gemm_phase(int wv, LAS unsigned char* lds, const Gemm g, const Sched& S, const Epi& E) {
  const int tid = fresh_tid(wv), wid = __builtin_amdgcn_readfirstlane(tid >> 6), lane = tid & 63, wr = wid >> 2, wc = wid & 3, fr = lane & 15, fq = lane >> 4;
  const int K = g.K, nt = K / BK;
  unsigned voffA[2], voffB[2], voffBu[2];
#pragma unroll
  for (int i = 0; i < 2; ++i) { int R, C; stage_rc(tid * 16 + i * 8192, R, C); const int Rb = Epi::PERM ? ((R & ~31) + perm32(R & 31)) : R;
    voffA[i] = (unsigned)(R * g.lda + C) * 2u; voffB[i] = (unsigned)(Rb * g.ldb + C) * 2u;
    if constexpr (Epi::BMODE == 1) voffBu[i] = (unsigned)((127 - Rb) * g.ldb + C) * 2u;
    else voffBu[i] = voffB[i]; }
  const size_t kstep = (size_t)(BK * 2);
  const size_t hstepA = (size_t)HALF * g.lda * 2, hstepB = (size_t)HALF * g.ldb * 2;
  const unsigned ldsw = (unsigned)wid * 1024u;
  const int aoff = lds_byte(wr * 64 + fr, fq * 8), boff = lds_byte(wc * 32 + fr, fq * 8);
#define PG8_SA(b, h) (((b) * 2 + (h)) * HTB)
#define PG8_SB(b, h) ((4 + (b) * 2 + (h)) * HTB)
#define PG8_STAGE(bufoff, gbase, voff) do { _Pragma("unroll") for (int _i = 0; _i < 2; ++_i) \
    __builtin_amdgcn_global_load_lds((const unsigned*)((const char*)(gbase) + (voff)[_i]), (LAS unsigned*)(lds + (bufoff) + ldsw + _i * 8192), 16, 0, 0); } while (0)
#define PG8_LDA(dst, b, h) do { _Pragma("unroll") for (int m = 0; m < 4; ++m) _Pragma("unroll") for (int k = 0; k < 2; ++k) dst[m][k] = *(const LAS bf16x8*)(lds + PG8_SA(b, h) + aoff + m * 2048 + k * 1024); } while (0)
#define PG8_LDB(dst, b, h) do { _Pragma("unroll") for (int n = 0; n < 2; ++n) _Pragma("unroll") for (int k = 0; k < 2; ++k) dst[n][k] = *(const LAS bf16x8*)(lds + PG8_SB(b, h) + boff + n * 2048 + k * 1024); } while (0)
#define PG8_MMA(ai, bj, At, Bt) do { __builtin_amdgcn_s_setprio(1); _Pragma("unroll") for (int m = 0; m < 4; ++m) _Pragma("unroll") for (int n = 0; n < 2; ++n) _Pragma("unroll") for (int k = 0; k < 2; ++k) \
    acc[ai][bj][m][n] = __builtin_amdgcn_mfma_f32_16x16x32_bf16(Bt[n][k], At[m][k], acc[ai][bj][m][n], 0, 0, 0); __builtin_amdgcn_s_setprio(0); } while (0)
#define PG8_WAIT_V(n) asm volatile("s_waitcnt vmcnt(" #n ")" ::: "memory")
#define PG8_WAIT_L(n) asm volatile("s_waitcnt lgkmcnt(" #n ")" ::: "memory")
#define PG8_BAR __builtin_amdgcn_s_barrier()
#define PG8_SCHED __builtin_amdgcn_sched_barrier(0)
  Unit cur, nxt; int ui = 0;
  if (!S.next(0, cur)) return;
  f32x4 acc[2][2][4][2];
#pragma unroll
  for (int a = 0; a < 2; ++a)
#pragma unroll
    for (int b = 0; b < 2; ++b)
#pragma unroll
      for (int m = 0; m < 4; ++m)
#pragma unroll
        for (int n = 0; n < 2; ++n) acc[a][b][m][n] = (f32x4){0.f, 0.f, 0.f, 0.f};
  bf16x8 At[4][2], B0[2][2], B1[2][2];
  const char* cA = cur.a; const char* cB = cur.b; const char* cBu = (Epi::BMODE == 1) ? cur.b2 : cur.b + hstepB;
  static_assert(SP2, "only the SP2 loop is kept");
  PG8_STAGE(PG8_SB(0, 0), cB, voffB); PG8_STAGE(PG8_SB(0, 1), cBu, voffBu); PG8_STAGE(PG8_SA(0, 0), cA, voffA); PG8_STAGE(PG8_SA(0, 1), cA + hstepA, voffA);
  if (wr == 1) PG8_BAR;
  PG8_WAIT_V(2); PG8_BAR;
  PG8_STAGE(PG8_SB(1, 0), cB + kstep, voffB); PG8_STAGE(PG8_SA(1, 0), cA + kstep, voffA); PG8_STAGE(PG8_SB(1, 1), cBu + kstep, voffBu);
  PG8_WAIT_V(6); PG8_BAR;
  for (;;) {
    const bool has_next = S.next(ui + 1, nxt);
    const char* nA = has_next ? nxt.a : cA; const char* nB = has_next ? nxt.b : cB;
    const char* nBu = has_next ? ((Epi::BMODE == 1) ? nxt.b2 : nxt.b + hstepB) : cBu;
    for (int t = 0; t < nt; t += 2) {
      const bool last = (t == nt - 2);
      const char* a1 = cA + (size_t)(t + 1) * kstep;
      const char* a2 = last ? nA : cA + (size_t)(t + 2) * kstep; const char* b2 = last ? nB : cB + (size_t)(t + 2) * kstep;
      const char* a3 = a2 + kstep; const char* b3 = b2 + kstep;
      const char* b2u = last ? nBu : cBu + (size_t)(t + 2) * kstep; const char* b3u = b2u + kstep;
      PG8_LDB(B0, 0, 0); PG8_LDB(B1, 0, 1); PG8_SCHED; PG8_LDA(At, 0, 0); PG8_STAGE(PG8_SA(1, 1), a1 + hstepA, voffA);
      PG8_WAIT_V(8); PG8_WAIT_L(0); PG8_BAR; PG8_MMA(0, 0, At, B0); PG8_MMA(0, 1, At, B1); PG8_BAR; PG8_SCHED;
      PG8_LDA(At, 0, 1); PG8_STAGE(PG8_SB(0, 0), b2, voffB); PG8_STAGE(PG8_SB(0, 1), b2u, voffBu); PG8_STAGE(PG8_SA(0, 0), a2, voffA);
      PG8_WAIT_V(8); PG8_WAIT_L(0); PG8_BAR; PG8_MMA(1, 0, At, B0); PG8_MMA(1, 1, At, B1); PG8_BAR; PG8_SCHED;
      PG8_LDB(B0, 1, 0); PG8_LDB(B1, 1, 1); PG8_SCHED; PG8_LDA(At, 1, 0); PG8_STAGE(PG8_SA(0, 1), a2 + hstepA, voffA);
      PG8_WAIT_V(8); PG8_WAIT_L(0); PG8_BAR; PG8_MMA(0, 0, At, B0); PG8_MMA(0, 1, At, B1); PG8_BAR; PG8_SCHED;
      PG8_LDA(At, 1, 1); PG8_STAGE(PG8_SB(1, 0), b3, voffB); PG8_STAGE(PG8_SB(1, 1), b3u, voffBu); PG8_STAGE(PG8_SA(1, 0), a3, voffA);
      PG8_WAIT_V(8); PG8_WAIT_L(0); PG8_BAR; PG8_MMA(1, 0, At, B0); PG8_MMA(1, 1, At, B1); PG8_BAR; PG8_SCHED;
    }
    if constexpr (ALIGN_EPI) { if (wr == 0) PG8_BAR; }
    E(acc, cur, wr, wc, fr, fq);
    if (!has_next) break;
#pragma unroll
    for (int a = 0; a < 2; ++a)
#pragma unroll
      for (int b = 0; b < 2; ++b)
#pragma unroll
        for (int m = 0; m < 4; ++m)
#pragma unroll
          for (int n = 0; n < 2; ++n) acc[a][b][m][n] = (f32x4){0.f, 0.f, 0.f, 0.f};
    cur = nxt; cA = nA; cB = nB; cBu = nBu; ++ui;
    if constexpr (ALIGN_EPI) { if (wr == 1) PG8_BAR; }
  }
  PG8_WAIT_V(0);
  if constexpr (!ALIGN_EPI) { if (wr == 0) PG8_BAR; }
  PG8_BAR;
#undef PG8_SA
#undef PG8_SB
#undef PG8_STAGE
#undef PG8_LDA
#undef PG8_LDB
#undef PG8_MMA
#undef PG8_WAIT_V
#undef PG8_WAIT_L
#undef PG8_BAR
#undef PG8_SCHED
}
}

#define XB_TMO      128
#define XB_XCNT(j)  (256  + 64 * (j))
#define XB_XSUB(j)  (1280 + 64 * (j))
#define XB_XGEN(j)  (2304 + 64 * (j))
#define XB_TOP      3328
#define XB_TOPGEN   3392
#define XCD_BAR_WORDS 3456
#define XB_SPIN_CAP (1u << 22)
__device__ __forceinline__ unsigned xb_ld(unsigned* p)              { return __hip_atomic_load(p, __ATOMIC_RELAXED, __HIP_MEMORY_SCOPE_AGENT); }
__device__ __forceinline__ unsigned xb_add(unsigned* p, unsigned v) { return __hip_atomic_fetch_add(p, v, __ATOMIC_RELAXED, __HIP_MEMORY_SCOPE_AGENT); }
__device__ __forceinline__ unsigned xb_xcc_id() { return (unsigned)__builtin_amdgcn_s_getreg((3 << 11) | 20) & 0xFu; }
#define XB_SPIN(cond, bar) do { unsigned _sp = 0; while (cond) { __builtin_amdgcn_s_sleep(1); \
    if ((++_sp & 255u) == 0u) { if (xb_ld(&(bar)[XB_TMO])) break; if (_sp > XB_SPIN_CAP) { atomicAdd(&(bar)[XB_TMO], 1u); break; } } } } while (0)
struct XcdBarrier { unsigned* bar; unsigned x; volatile LAS unsigned* st; };
__device__ __forceinline__ XcdBarrier xcd_barrier_post(unsigned* bar, volatile LAS unsigned* st) {
  XcdBarrier b; b.bar = bar; b.x = xb_xcc_id(); b.st = st;
  if (threadIdx.x == 0) (void)xb_add(&bar[XB_XCNT(b.x)], 1u);
  return b;
}
__device__ __forceinline__ void xcd_barrier_complete(unsigned* bar, unsigned x, unsigned& nloc, unsigned& nx) {
  const unsigned G = gridDim.x * gridDim.y * gridDim.z;
  unsigned sum, cnt, mine, sp = 0u;
  for (;;) {
    sum = 0u; cnt = 0u; mine = 0u;
#pragma unroll
    for (unsigned j = 0; j < 16; ++j) { const unsigned c = xb_ld(&bar[XB_XCNT(j)]); sum += c; cnt += (c > 0u) ? 1u : 0u; mine = (j == x) ? c : mine; }
    if (sum == G) break;
    __builtin_amdgcn_s_sleep(1);
    if ((++sp & 255u) == 0u) { if (xb_ld(&bar[XB_TMO])) break; if (sp > XB_SPIN_CAP) { atomicAdd(&bar[XB_TMO], 1u); break; } }
  }
  nloc = mine > 0u ? mine : 1u; nx = cnt > 0u ? cnt : 1u;
}
__device__ __forceinline__ void xcd_barrier(const XcdBarrier& b, int wv) {
  asm volatile("s_waitcnt vmcnt(0)" ::: "memory");
  __syncthreads();
  if (wv == 0 && __builtin_amdgcn_mbcnt_hi(~0u, __builtin_amdgcn_mbcnt_lo(~0u, 0u)) == 0u) {
    unsigned* bar = fresh_ptr(b.bar); unsigned bxx = __builtin_amdgcn_readfirstlane(b.x); asm volatile("" : "+s"(bxx));
    __builtin_amdgcn_s_waitcnt(0);
    unsigned nloc = b.st[0], nx = b.st[1];
    if (nloc == 0u) { xcd_barrier_complete(bar, bxx, nloc, nx); b.st[0] = nloc; b.st[1] = nx; }
    const unsigned old = xb_add(&bar[XB_XSUB(bxx)], 1u);
    const unsigned gen = old / nloc;
    if (old + 1u == (gen + 1u) * nloc) {
      __builtin_amdgcn_fence(__ATOMIC_RELEASE, "agent");
      asm volatile("s_waitcnt vmcnt(0)" ::: "memory");
      const unsigned og = xb_add(&bar[XB_TOP], 1u);
      const unsigned tg = og / nx;
      if (og + 1u == (tg + 1u) * nx) xb_add(&bar[XB_TOPGEN], 1u);
      else XB_SPIN(xb_ld(&bar[XB_TOPGEN]) == tg, bar);
      __builtin_amdgcn_fence(__ATOMIC_ACQUIRE, "agent");
      xb_add(&bar[XB_XGEN(bxx)], 1u);
      asm volatile("s_waitcnt vmcnt(0)" ::: "memory");
    } else {
      XB_SPIN(xb_ld(&bar[XB_XGEN(bxx)]) == gen, bar);
      __builtin_amdgcn_fence(__ATOMIC_ACQUIRE, "agent");
      asm volatile("s_waitcnt vmcnt(0)" ::: "memory");
    }
  }
  __syncthreads();
}

__device__ __forceinline__ int lat_pm(int j) { return (j >> 3) * 9 + (j & 7); }
struct PlainOrder : pg8::StaticOrder {
  int adiv; size_t acol; int lat;
  __device__ void init2(const void* A_, const void* B_, int M, int N, int lda, int ldb, int G_, int c_, int adiv_ = 1 << 30, size_t acol_ = 0, int lat_ = 0) { init(A_, B_, M, N, lda, ldb, G_, c_); adiv = adiv_; acol = acol_; lat = lat_; }
  __device__ bool next(int i, pg8::Unit& u) const {
    if (!pg8::StaticOrder::next(i, u)) {
      const long L = (long)i * G + c - nwg; if (lat != 2 || L < 0 || L >= 32) return false;
      u.pm = (int)(L >> 2) * 9 + 8; u.pn = 4 + (int)(L & 3); u.a = A + (size_t)u.pm * ta; u.b = B + (size_t)u.pn * tb; return true; }
    if (lat) { u.pm = lat_pm(u.pm); u.a = A + (size_t)u.pm * ta; } u.a += (size_t)(u.pn / adiv) * acol; return true; }
};
struct CtxKOrder {
  int G, c; const char* A; const char* B;
  __device__ bool next(int i, pg8::Unit& u) const { const int L = i * G + c; if (L >= 32) return false; u.pm = (L >> 2) * 9 + 8; u.pn = 4 + (L & 3);
    u.a = A + (size_t)u.pm * 256 * 2048; u.b = B + (size_t)u.pn * 256 * 2048; return true; }
};
struct BatchOrder {
  int nb, nM, nN, G, c, pm_off; const char* A; const char* B; size_t ta, bb, tb;
  __device__ bool next(int i, pg8::Unit& u) const {
    const long L = (long)i * G + c; if (L >= (long)nb * nM * nN) return false;
    const int bl = (int)(L % nb), rem = (int)(L / nb), pn = rem % nN, pml = rem / nN;
    u.pm = bl * 9 + pm_off + pml; u.pn = pn; u.a = A + (size_t)pml * ta; u.b = B + (size_t)bl * bb + (size_t)pn * tb; return true;
  }
};

__device__ __forceinline__ void st8(bf16_t* p, f32x4 v0, f32x4 v1) { u32x4 w; w.x = cvt_pk_bf16(v0[0], v0[1]); w.y = cvt_pk_bf16(v0[2], v0[3]); w.z = cvt_pk_bf16(v1[0], v1[1]); w.w = cvt_pk_bf16(v1[2], v1[3]); *(u32x4*)p = w; }
__device__ __forceinline__ f32x4 silu4(f32x4 v) { return (f32x4){fast_silu(v[0]), fast_silu(v[1]), fast_silu(v[2]), fast_silu(v[3])}; }
__device__ __forceinline__ f32x4 sigm4(f32x4 v) { return (f32x4){fast_sigmoid(v[0]), fast_sigmoid(v[1]), fast_sigmoid(v[2]), fast_sigmoid(v[3])}; }
__device__ __forceinline__ void ld8(const bf16_t* p, f32x4& a, f32x4& b) { const u32x4 w = *(const u32x4*)p; a = (f32x4){bf_lo(w.x), bf_hi(w.x), bf_lo(w.y), bf_hi(w.y)}; b = (f32x4){bf_lo(w.z), bf_hi(w.z), bf_lo(w.w), bf_hi(w.w)}; }

struct EpiMain {
  static constexpr bool PERM = true; static constexpr int BMODE = 0;
  bf16_t *QB, *KB, *ZA, *U, *BZ, *ZF, *GT; const float *ropec, *ropes;
  __device__ __forceinline__ void operator()(const f32x4 (&acc)[2][2][4][2], const pg8::Unit& u, int wr, int wc, int fr, int fq) const {
    const int pn = u.pn; const size_t row0 = (size_t)u.pm * 256 + wr * 64 + fr; const int cin = wc * 32 + 8 * fq;
    if (pn < 8) {
      const bool isq = pn < 4; bf16_t* O = isq ? QB : KB; const int colt = (pn & 3) * 256;
      const int t9 = u.pm % 9; const bool ctx = (t9 == 8);
      const float sc = isq ? QSCALE : 1.0f;
#pragma unroll
      for (int ai = 0; ai < 2; ++ai)
#pragma unroll
        for (int m = 0; m < 4; ++m) {
          const int p = (wc & 1) ? (16 * m + fr) : (4 * t9 + 2 * ai + wr);
          f32x4 cs = {1.f, 1.f, 1.f, 1.f}, sn = {0.f, 0.f, 0.f, 0.f};
          if (!ctx) { cs = *(const f32x4*)(ropec + p * 16 + 4 * fq); sn = *(const f32x4*)(ropes + p * 16 + 4 * fq); }
#pragma unroll
          for (int bj = 0; bj < 2; ++bj) {
            const f32x4 x1 = acc[ai][bj][m][0], x2 = acc[ai][bj][m][1];
            const f32x4 v0 = (x1 * cs - x2 * sn) * sc, v1 = (x2 * cs + x1 * sn) * sc;
            st8(O + (row0 + ai * 128 + m * 16) * 1024 + colt + bj * 128 + cin, v0, v1);
          }
        }
    } else if (pn < 12 || (pn >= 28 && pn < 32)) {
      bf16_t* O = pn < 12 ? ZA : ZF; const int colt = (pn < 12 ? pn - 8 : pn - 28) * 256;
#pragma unroll
      for (int ai = 0; ai < 2; ++ai)
#pragma unroll
        for (int m = 0; m < 4; ++m)
#pragma unroll
          for (int bj = 0; bj < 2; ++bj)
            st8(O + (row0 + ai * 128 + m * 16) * 1024 + colt + bj * 128 + cin, silu4(acc[ai][bj][m][0]), silu4(acc[ai][bj][m][1]));
    } else if (pn < 20) {
      const int colt = (pn - 12) * 128;
#pragma unroll
      for (int ai = 0; ai < 2; ++ai)
#pragma unroll
        for (int m = 0; m < 4; ++m)
          st8(U + (row0 + ai * 128 + m * 16) * 1024 + colt + cin, acc[ai][0][m][0] * acc[ai][1][m][0], acc[ai][0][m][1] * acc[ai][1][m][1]);
    } else if (pn < 28) {
      const int colt = (pn - 20) * 128;
#pragma unroll
      for (int ai = 0; ai < 2; ++ai)
#pragma unroll
        for (int m = 0; m < 4; ++m)
          st8(BZ + (row0 + ai * 128 + m * 16) * 1024 + colt + cin, acc[ai][0][m][0] * silu4(acc[ai][1][m][0]), acc[ai][0][m][1] * silu4(acc[ai][1][m][1]));
    } else {
      const int colt = (pn - 32) * 256;
#pragma unroll
      for (int ai = 0; ai < 2; ++ai)
#pragma unroll
        for (int m = 0; m < 4; ++m)
#pragma unroll
          for (int bj = 0; bj < 2; ++bj)
            st8(GT + (row0 + ai * 128 + m * 16) * 3072 + colt + bj * 128 + cin, sigm4(acc[ai][bj][m][0]), sigm4(acc[ai][bj][m][1]));
    }
  }
};

struct EpiT {
  static constexpr bool PERM = true; static constexpr int BMODE = 0;
  bf16_t *VT, *HT, *HTC;
  __device__ __forceinline__ void operator()(const f32x4 (&acc)[2][2][4][2], const pg8::Unit& u, int wr, int wc, int fr, int fq) const {
    const int cin = wc * 32 + 8 * fq; const int bl = u.pn / 9, t9 = u.pn % 9;
    if (u.pm < 4) {
      const int ch0 = u.pm * 256 + wr * 64 + fr; bf16_t* base = VT + (size_t)bl * 1024 * TB + t9 * 256;
#pragma unroll
      for (int ai = 0; ai < 2; ++ai)
#pragma unroll
        for (int m = 0; m < 4; ++m)
#pragma unroll
          for (int bj = 0; bj < 2; ++bj)
            st8(base + (size_t)(ch0 + ai * 128 + m * 16) * TB + bj * 128 + cin, acc[ai][bj][m][0], acc[ai][bj][m][1]);
    } else {
      bf16_t* base; size_t ld; int sinoff;
      if (t9 < 8) { base = HT + (size_t)bl * 1024 * 4096 + t9 * 256; ld = 4096; sinoff = 2048; } else { base = HTC + (size_t)bl * 1024 * 512; ld = 512; sinoff = 256; }
#pragma unroll
      for (int ai = 0; ai < 2; ++ai) {
        const int g = (u.pm - 4) * 2 + ai;
#pragma unroll
        for (int m = 0; m < 4; ++m) {
          const int s = wr * 64 + m * 16 + fr; const bool is_cos = s <= 64; const int k2 = is_cos ? s : s - 64; const bool edge = (k2 == 0) || (k2 == 64);
          bf16_t* p1 = base + (size_t)(g * 128 + k2) * ld + (is_cos ? 0 : sinoff) + cin;
          bf16_t* p2 = edge ? base + (size_t)(g * 128 + k2) * ld + sinoff + cin : base + (size_t)(g * 128 + 128 - k2) * ld + (is_cos ? 0 : sinoff) + cin;
          const float sg = edge ? 0.f : (is_cos ? 1.f : -1.f);
#pragma unroll
          for (int bj = 0; bj < 2; ++bj) { st8(p1 + bj * 128, acc[ai][bj][m][0], acc[ai][bj][m][1]); st8(p2 + bj * 128, acc[ai][bj][m][0] * sg, acc[ai][bj][m][1] * sg); }
        }
      }
    }
  }
};

struct EpiMulBf16 {
  static constexpr bool PERM = true; static constexpr int BMODE = 0;
  bf16_t* O; const bf16_t* Mul; int ldo, ldm, ooff, moff, octx;
  __device__ __forceinline__ void operator()(const f32x4 (&acc)[2][2][4][2], const pg8::Unit& u, int wr, int wc, int fr, int fq) const {
    const size_t row0 = (size_t)u.pm * 256 + wr * 64 + fr; const int col0 = u.pn * 256 + wc * 32 + 8 * fq;
    const size_t orow0 = octx ? (size_t)(u.pm / 9) * 256 + wr * 64 + fr : row0;
#pragma unroll
    for (int ai = 0; ai < 2; ++ai) {
      u32x4 gw[4][2];
#pragma unroll
      for (int m = 0; m < 4; ++m)
#pragma unroll
        for (int bj = 0; bj < 2; ++bj) gw[m][bj] = *(const u32x4*)(Mul + (row0 + ai * 128 + m * 16) * ldm + moff + col0 + bj * 128);
#pragma unroll
      for (int m = 0; m < 4; ++m)
#pragma unroll
        for (int bj = 0; bj < 2; ++bj) {
          const u32x4 w = gw[m][bj];
          const f32x4 g0 = {bf_lo(w.x), bf_hi(w.x), bf_lo(w.y), bf_hi(w.y)}, g1 = {bf_lo(w.z), bf_hi(w.z), bf_lo(w.w), bf_hi(w.w)};
          st8(O + (orow0 + ai * 128 + m * 16) * ldo + ooff + col0 + bj * 128, acc[ai][bj][m][0] * g0, acc[ai][bj][m][1] * g1);
        }
      asm volatile("" ::: "memory");
    }
  }
};

struct TripleOrder {
  pg8::StaticOrder so; const char* W; int lat;
  __device__ bool next(int i, pg8::Unit& u) const {
    const int br = i % 3;
    if (!so.next(i / 3, u)) return false;
    if (lat) { u.pm = lat_pm(u.pm); u.a = so.A + (size_t)u.pm * so.ta; }
    u.a += (size_t)br * 2048; u.b = W + ((size_t)br * 1024 + (size_t)u.pn * 256) * 1024 * 2; u.pn |= br << 8; return true;
  }
};
struct EpiAcc {
  static constexpr bool PERM = true; static constexpr int BMODE = 0;
  bf16_t* Mout; const bf16_t* GT; float* scr;
  __device__ __forceinline__ void operator()(const f32x4 (&acc)[2][2][4][2], const pg8::Unit& u, int wr, int wc, int fr, int fq) const {
    const int br = u.pn >> 8, pn = u.pn & 255; const int tid = (wr * 4 + wc) * 64 + fq * 16 + fr;
    const size_t row0 = (size_t)u.pm * 256 + wr * 64 + fr; const int col0 = pn * 256 + wc * 32 + 8 * fq;
    u32x4* sp0 = (u32x4*)scr + tid;
#pragma unroll
    for (int ai = 0; ai < 2; ++ai) {
      __attribute__((address_space(1))) u32x4* sp = (__attribute__((address_space(1))) u32x4*)sp0; asm volatile("" : "+v"(sp));
      u32x4 gw[4][2], sw[4][2];
#pragma unroll
      for (int m = 0; m < 4; ++m)
#pragma unroll
        for (int bj = 0; bj < 2; ++bj) gw[m][bj] = *(const u32x4*)(GT + (row0 + ai * 128 + m * 16) * 3072 + br * 1024 + col0 + bj * 128);
      if (br > 0) {
#pragma unroll
        for (int m = 0; m < 4; ++m)
#pragma unroll
          for (int bj = 0; bj < 2; ++bj) sw[m][bj] = sp[(size_t)((ai * 4 + m) * 2 + bj) * 512];
      }
#pragma unroll
      for (int m = 0; m < 4; ++m)
#pragma unroll
        for (int bj = 0; bj < 2; ++bj) {
          const u32x4 w = gw[m][bj];
          const f32x4 g0 = {bf_lo(w.x), bf_hi(w.x), bf_lo(w.y), bf_hi(w.y)}, g1 = {bf_lo(w.z), bf_hi(w.z), bf_lo(w.w), bf_hi(w.w)};
          f32x4 v0 = acc[ai][bj][m][0] * g0, v1 = acc[ai][bj][m][1] * g1;
          if (br > 0) { const u32x4 s = sw[m][bj]; v0 += (f32x4){bf_lo(s.x), bf_hi(s.x), bf_lo(s.y), bf_hi(s.y)}; v1 += (f32x4){bf_lo(s.z), bf_hi(s.z), bf_lo(s.w), bf_hi(s.w)}; }
          u32x4 o; o.x = cvt_pk_bf16(v0[0], v0[1]); o.y = cvt_pk_bf16(v0[2], v0[3]); o.z = cvt_pk_bf16(v1[0], v1[1]); o.w = cvt_pk_bf16(v1[2], v1[3]);
          if (br < 2) sp[(size_t)((ai * 4 + m) * 2 + bj) * 512] = o;
          else *(u32x4*)(Mout + (row0 + ai * 128 + m * 16) * 1024 + col0 + bj * 128) = o;
        }
      asm volatile("" ::: "memory");
    }
  }
};

struct EpiRes {
  static constexpr bool PERM = false; static constexpr int BMODE = 0;
  const float *base_lat, *base_ctx; float *out_lat, *out_ctx; const float* mod; int chunk;
  __device__ __forceinline__ void operator()(const f32x4 (&acc)[2][2][4][2], const pg8::Unit& u, int wr, int wc, int fr, int fq) const {
    const int bl = u.pm / 9, t9 = u.pm % 9, b = chunk * CB + bl; const bool ctx = (t9 == 8);
    const size_t rbase = ctx ? (size_t)b * CTXL : (size_t)b * SEQ + t9 * 256;
    const __attribute__((address_space(1))) float* bs = (const __attribute__((address_space(1))) float*)(ctx ? base_ctx : base_lat) + rbase * 1024; __attribute__((address_space(1))) float* os = (__attribute__((address_space(1))) float*)(ctx ? out_ctx : out_lat) + rbase * 1024;
    const float* gate = mod + (size_t)(ctx ? 16 : b) * 3072 + 2048;
    const int col0 = u.pn * 256 + wc * 32 + 4 * fq;
#pragma unroll
    for (int bj = 0; bj < 2; ++bj)
#pragma unroll
      for (int n = 0; n < 2; ++n) {
        const f32x4 gv = *(const f32x4*)(gate + col0 + bj * 128 + n * 16);
        f32x4 xv[2][4];
#pragma unroll
        for (int ai = 0; ai < 2; ++ai)
#pragma unroll
          for (int m = 0; m < 4; ++m) xv[ai][m] = *(const __attribute__((address_space(1))) f32x4*)(bs + (size_t)(ai * 128 + wr * 64 + m * 16 + fr) * 1024 + col0 + bj * 128 + n * 16);
#pragma unroll
        for (int ai = 0; ai < 2; ++ai)
#pragma unroll
          for (int m = 0; m < 4; ++m) *(__attribute__((address_space(1))) f32x4*)(os + (size_t)(ai * 128 + wr * 64 + m * 16 + fr) * 1024 + col0 + bj * 128 + n * 16) = xv[ai][m] + gv * acc[ai][bj][m][n];
        asm volatile("" ::: "memory");
      }
  }
};

struct CtxOrder {
  int G, c; const char* A; const char* B; size_t ta, tb; int ctxA, bsplit;
  __device__ bool next(int i, pg8::Unit& u) const {
    const int L = i * G + c; if (L >= 96) return false;
    const int j = L / 12, q = L % 12, br = q >> 2;
    u.pm = j * 9 + 8; u.pn = bsplit ? q : ((q & 3) | (br << 8));
    u.a = A + (size_t)(ctxA ? j : u.pm) * ta + (size_t)br * 2048; u.b = B + (size_t)(bsplit ? q : (q & 3)) * tb; return true;
  }
};
struct EpiPart {
  static constexpr bool PERM = false; static constexpr int BMODE = 0;
  float* PX;
  __device__ __forceinline__ void operator()(const f32x4 (&acc)[2][2][4][2], const pg8::Unit& u, int wr, int wc, int fr, int fq) const {
    const int br = u.pn >> 8, pn = u.pn & 255;
    __attribute__((address_space(1))) float* os = (__attribute__((address_space(1))) float*)PX + ((size_t)br * 2048 + (size_t)(u.pm / 9) * 256) * 1024;
    const int col0 = pn * 256 + wc * 32 + 4 * fq;
#pragma unroll
    for (int bj = 0; bj < 2; ++bj)
#pragma unroll
      for (int n = 0; n < 2; ++n)
#pragma unroll
        for (int ai = 0; ai < 2; ++ai)
#pragma unroll
          for (int m = 0; m < 4; ++m)
            *(__attribute__((address_space(1))) f32x4*)(os + (size_t)(ai * 128 + wr * 64 + m * 16 + fr) * 1024 + col0 + bj * 128 + n * 16) = acc[ai][bj][m][n];
  }
};


struct MirrorOrder {
  int G, c; const char* A; const char* HNb; const char* SBLb; const char* SBCb;
  __device__ bool next(int i, pg8::Unit& u) const {
    const int L = i * G + c; if (L >= 288) return false;
    const int ft = L & 3, tt = L >> 2, bl = tt / 9, t9 = tt % 9; const size_t rowb = (size_t)bl * TB;
    u.pm = 4 + ft; u.pn = tt; u.a = A + (size_t)(1024 + ft * 256) * 2048;
    if (t9 == 0) { u.b = HNb + rowb * 2048; u.b2 = SBLb + (size_t)bl * 128 * 2048; }
    else if (t9 < 8) { u.b = HNb + (rowb + 128 * t9) * 2048; u.b2 = HNb + (rowb + SEQ - 128 * t9 - 127) * 2048; }
    else { u.b = HNb + (rowb + SEQ) * 2048; u.b2 = SBCb + (size_t)bl * 128 * 2048; }
    return true;
  }
};
struct EpiT2 {
  static constexpr bool PERM = true; static constexpr int BMODE = 1;
  bf16_t *HT, *HTC; float *NYQ, *NYQC;
  __device__ __forceinline__ void operator()(const f32x4 (&acc)[2][2][4][2], const pg8::Unit& u, int wr, int wc, int fr, int fq) const {
    asm volatile("" : "+v"(fr), "+v"(fq), "+s"(wr), "+s"(wc));
    const int ft = u.pm - 4, bl = u.pn / 9, t9 = u.pn % 9, j0 = wc * 32 + 8 * fq;
    bf16_t* base; size_t ld; int sinoff, n0;
    if (t9 < 8) { base = HT + (size_t)bl * 1024 * 2048; ld = 2048; sinoff = 1024; n0 = 128 * t9; } else { base = HTC + (size_t)bl * 1024 * 256; ld = 256; sinoff = 128; n0 = 0; }
    const bool first = (n0 == 0) && (j0 == 0);
#pragma unroll
    for (int ai = 0; ai < 2; ++ai) {
      const int g = ft * 2 + ai;
#pragma unroll
      for (int m = 0; m < 4; ++m) {
        const int s = wr * 64 + m * 16 + fr; const bool is_cos = s <= 64; const int k2 = is_cos ? s : s - 64; const bool edge = (k2 == 0) || (k2 == 64);
        const f32x4 a0 = acc[ai][0][m][0], a1 = acc[ai][0][m][1], b0 = acc[ai][1][m][0], b1 = acc[ai][1][m][1];
        f32x4 v0 = is_cos ? a0 + b0 : a0 - b0; const f32x4 v1 = is_cos ? a1 + b1 : a1 - b1;
        if (first) { v0[0] = is_cos ? a0[0] : 0.f;
          if (is_cos) { float* nq = NYQ + (t9 < 8 ? 0 : (int)((WS_NYQC - WS_NYQ) / 4)) + bl * 1024 + g * 128; nq[k2] = b0[0]; if (!edge) nq[128 - k2] = b0[0]; } }
        bf16_t* p1 = base + (size_t)(g * 128 + k2) * ld + (is_cos ? 0 : sinoff) + n0 + j0;
        bf16_t* p2 = edge ? base + (size_t)(g * 128 + k2) * ld + sinoff + n0 + j0 : base + (size_t)(g * 128 + 128 - k2) * ld + (is_cos ? 0 : sinoff) + n0 + j0;
        const float sg = edge ? 0.f : (is_cos ? 1.f : -1.f);
        st8(p1, v0, v1); st8(p2, v0 * sg, v1 * sg);
      }
    }
  }
};
struct EpiFour {
  static constexpr bool PERM = true; static constexpr int BMODE = 0;
  bf16_t* O; const bf16_t* ZF; const float *NYQ, *NYQC;
  __device__ __forceinline__ void operator()(const f32x4 (&acc)[2][2][4][2], const pg8::Unit& u, int wr, int wc, int fr, int fq) const {
    const size_t row0 = (size_t)u.pm * 256 + wr * 64 + fr; const int col0 = u.pn * 256 + wc * 32 + 8 * fq;
    const int bl = u.pm / 9; const bool ctx = (u.pm % 9) == 8;
    const float* nq = (ctx ? NYQC : NYQ) + (size_t)bl * 1024 + col0;
    const float sc = (ctx ? 0.0625f : 0.022097086912079608f) * ((fr & 1) ? -1.f : 1.f);
    f32x4 ny[2][2];
#pragma unroll
    for (int bj = 0; bj < 2; ++bj) { ny[bj][0] = *(const f32x4*)(nq + bj * 128) * sc; ny[bj][1] = *(const f32x4*)(nq + bj * 128 + 4) * sc; }
#pragma unroll
    for (int ai = 0; ai < 2; ++ai) {
      u32x4 gw[4][2];
#pragma unroll
      for (int m = 0; m < 4; ++m)
#pragma unroll
        for (int bj = 0; bj < 2; ++bj) gw[m][bj] = *(const u32x4*)(ZF + (row0 + ai * 128 + m * 16) * 1024 + col0 + bj * 128);
#pragma unroll
      for (int m = 0; m < 4; ++m)
#pragma unroll
        for (int bj = 0; bj < 2; ++bj) {
          const u32x4 w = gw[m][bj];
          const f32x4 g0 = {bf_lo(w.x), bf_hi(w.x), bf_lo(w.y), bf_hi(w.y)}, g1 = {bf_lo(w.z), bf_hi(w.z), bf_lo(w.w), bf_hi(w.w)};
          st8(O + (row0 + ai * 128 + m * 16) * 3072 + 2048 + col0 + bj * 128, (acc[ai][bj][m][0] + ny[bj][0]) * g0, (acc[ai][bj][m][1] + ny[bj][1]) * g1);
        }
      asm volatile("" ::: "memory");
    }
  }
};

namespace att {
constexpr int KSTR = 272, VSTR = 136, KBYTES = 64 * KSTR, VBYTES = 128 * VSTR, STG = KBYTES + VBYTES;
constexpr int EXSTR = 132, YT_OFF = 2 * STG, YTSTR = 272;
__device__ __forceinline__ int crow(int r, int hi) { return (r & 3) + 8 * (r >> 2) + 4 * hi; }
#define MFMA32(a, b, c) __builtin_amdgcn_mfma_f32_32x32x16_bf16((a), (b), (c), 0, 0, 0)

__device__ __forceinline__ void attn_unit(int wv, LAS unsigned char* lds, const bf16_t* __restrict__ Qb, const bf16_t* __restrict__ Kb, const bf16_t* __restrict__ Vt, const bf16_t* __restrict__ ZA, bf16_t* __restrict__ ACAT,
                                          int bl, int head, int q0, int key0, int nkeys, int lam_bits, int lami_bits, const float* __restrict__ subw) {
  const int tid = fresh_tid(wv), lane = tid & 63, r = lane & 31, hh = lane >> 5, w = wv, map = w >> 2, qw = w & 3;
  const size_t rowbase = (size_t)bl * TB;
  bf16x8 qf[4];
  { const bf16_t* qp = Qb + (rowbase + q0 + qw * 32 + r) * 1024 + head * 128 + map * 64 + 8 * hh;
#pragma unroll
    for (int s = 0; s < 4; ++s) qf[s] = *(const bf16x8*)(qp + 16 * s); }
  const bf16_t* kg[2]; const bf16_t* vg[2]; unsigned kl[2], vl[2];
#pragma unroll
  for (int i = 0; i < 2; ++i) { const int c = tid + 512 * i;
    kg[i] = Kb + (rowbase + key0 + (c >> 4)) * 1024 + head * 128 + (c & 15) * 8; kl[i] = (unsigned)((c >> 4) * KSTR + (c & 15) * 16);
    vg[i] = Vt + (size_t)(bl * 1024 + head * 128 + (c >> 3)) * TB + key0 + (c & 7) * 8; vl[i] = (unsigned)(KBYTES + (c >> 3) * VSTR + (c & 7) * 16); }
  const int NT = nkeys >> 6;
  u32x4 kr[2], vr[2];
#define KSLOT(s) ((s) * KBYTES)
#define VSLOT(s) (3 * KBYTES + (s) * VBYTES)
#define ST_K(s) do { _Pragma("unroll") for (int i = 0; i < 2; ++i) *(LAS u32x4*)(lds + KSLOT(s) + kl[i]) = kr[i]; } while (0)
#define ST_V(s) do { _Pragma("unroll") for (int i = 0; i < 2; ++i) { *(LAS u32x2*)(lds + VSLOT(s) + vl[i]) = (u32x2){vr[i].x, vr[i].y}; *(LAS u32x2*)(lds + VSLOT(s) + vl[i] + 8) = (u32x2){vr[i].z, vr[i].w}; } } while (0)
#define LD_K(t) do { _Pragma("unroll") for (int i = 0; i < 2; ++i) kr[i] = *(const u32x4*)(kg[i] + (size_t)(t) * 64 * 1024); } while (0)
#define LD_V(t) do { _Pragma("unroll") for (int i = 0; i < 2; ++i) vr[i] = *(const u32x4*)(vg[i] + (t) * 64); } while (0)
#define QK(P0, P1, s) do { const LAS unsigned char* kb_ = lds + KSLOT(s) + r * KSTR + (map * 64 + 8 * hh) * 2; \
    _Pragma("unroll") for (int s_ = 0; s_ < 4; ++s_) { const bf16x8 a0 = *(const LAS bf16x8*)(kb_ + s_ * 32); const bf16x8 a1 = *(const LAS bf16x8*)(kb_ + 32 * KSTR + s_ * 32); \
      P0 = MFMA32(a0, qf[s_], P0); P1 = MFMA32(a1, qf[s_], P1); } } while (0)
  { u32x4 pk_[3][2], pv_[2][2];
#pragma unroll
    for (int t_ = 0; t_ < 3; ++t_)
#pragma unroll
      for (int i = 0; i < 2; ++i) { pk_[t_][i] = *(const u32x4*)(kg[i] + (size_t)t_ * 64 * 1024); if (t_ < 2) pv_[t_][i] = *(const u32x4*)(vg[i] + t_ * 64); }
#pragma unroll
    for (int t_ = 0; t_ < 3; ++t_)
#pragma unroll
      for (int i = 0; i < 2; ++i) { *(LAS u32x4*)(lds + KSLOT(t_) + kl[i]) = pk_[t_][i];
        if (t_ < 2) { *(LAS u32x2*)(lds + VSLOT(t_) + vl[i]) = (u32x2){pv_[t_][i].x, pv_[t_][i].y}; *(LAS u32x2*)(lds + VSLOT(t_) + vl[i] + 8) = (u32x2){pv_[t_][i].z, pv_[t_][i].w}; } } }
  __syncthreads();
  f32x16 o[4];
#pragma unroll
  for (int v = 0; v < 4; ++v)
#pragma unroll
    for (int i = 0; i < 16; ++i) o[v][i] = 0.f;
  float m_run, lsum = 0.f;
  f32x16 pA0, pA1, pB0, pB1;
  f32x16 zero16_;
#pragma unroll
  for (int i = 0; i < 16; ++i) zero16_[i] = 0.f;
#pragma unroll
  for (int i = 0; i < 16; ++i) { pA0[i] = 0.f; pA1[i] = 0.f; }
  QK(pA0, pA1, 0);
  { float mx = fmaxf(pA0[0], pA1[0]);
#pragma unroll
    for (int i = 1; i < 16; ++i) mx = fmaxf(mx, fmaxf(pA0[i], pA1[i]));
    mx = pl32_max(mx); m_run = __uint_as_float(cvt_pk_bf16(mx, 0.f) << 16);
#pragma unroll
    for (int i = 0; i < 16; ++i) { pA0[i] -= m_run; pA1[i] -= m_run; } }
  const u32x4 augA_ = {hh == 0 ? 0x3F80u : 0u, 0u, 0u, 0u};
#define SB() do {} while (0)
#define VFRAG(dst, sl, v) do { const LAS unsigned char* vb_ = lds + VSLOT(sl) + KBYTES + r * VSTR + (4 * hh) * 2 + (v) * 32 * VSTR; \
    _Pragma("unroll") for (int q_ = 0; q_ < 4; ++q_) { const u32x2 lo = *(const LAS u32x2*)(vb_ + q_ * 32), hi = *(const LAS u32x2*)(vb_ + q_ * 32 + 16); dst[q_] = (u32x4){lo.x, lo.y, hi.x, hi.y}; } } while (0)
#define BODY(PA0, PA1, PB0, PB1, t, HAS_NEXT, DO_BAR) do { \
    const int sl_ = (t) & 3; \
    bf16x8 kf_[4]; u32x4 vfa_[4], vfb_[4]; \
    const LAS unsigned char* kb_ = lds + KSLOT((sl_ + 1) & 3) + r * KSTR + (map * 64 + 8 * hh) * 2; \
    if ((t) + 3 < NT) LD_K((t) + 3); if ((t) + 2 < NT) LD_V((t) + 2); \
    if (HAS_NEXT) { \
      _Pragma("unroll") for (int s_ = 0; s_ < 4; ++s_) kf_[s_] = *(const LAS bf16x8*)(kb_ + s_ * 32); } \
    VFRAG(vfa_, sl_, 0); \
    SB(); \
    float ps_ = 0.f; \
    if (HAS_NEXT) { \
      const u32x4 augB_ = {hh == 0 ? (cvt_pk_bf16(-m_run, 0.f) & 0xffffu) : 0u, 0u, 0u, 0u}; \
      PB0 = MFMA32(__builtin_bit_cast(bf16x8, augA_), __builtin_bit_cast(bf16x8, augB_), zero16_); \
      PB1 = MFMA32(__builtin_bit_cast(bf16x8, augA_), __builtin_bit_cast(bf16x8, augB_), zero16_); \
      _Pragma("unroll") for (int s_ = 0; s_ < 4; ++s_) PB0 = MFMA32(kf_[s_], qf[s_], PB0); } \
    _Pragma("unroll") for (int i = 0; i < 16; ++i) { PA0[i] = __builtin_amdgcn_exp2f(PA0[i]); ps_ += PA0[i]; } \
    SB(); \
    if (HAS_NEXT) { \
      _Pragma("unroll") for (int s_ = 0; s_ < 4; ++s_) kf_[s_] = *(const LAS bf16x8*)(kb_ + 32 * KSTR + s_ * 32); \
      _Pragma("unroll") for (int s_ = 0; s_ < 4; ++s_) PB1 = MFMA32(kf_[s_], qf[s_], PB1); } \
    _Pragma("unroll") for (int i = 0; i < 16; ++i) { PA1[i] = __builtin_amdgcn_exp2f(PA1[i]); ps_ += PA1[i]; } \
    lsum += ps_; \
    bf16x8 pf_[4]; \
    _Pragma("unroll") for (int s2 = 0; s2 < 2; ++s2) { u32x4 a_, b_; \
      a_.x = cvt_pk_bf16(PA0[8 * s2 + 0], PA0[8 * s2 + 1]); a_.y = cvt_pk_bf16(PA0[8 * s2 + 2], PA0[8 * s2 + 3]); a_.z = cvt_pk_bf16(PA0[8 * s2 + 4], PA0[8 * s2 + 5]); a_.w = cvt_pk_bf16(PA0[8 * s2 + 6], PA0[8 * s2 + 7]); \
      b_.x = cvt_pk_bf16(PA1[8 * s2 + 0], PA1[8 * s2 + 1]); b_.y = cvt_pk_bf16(PA1[8 * s2 + 2], PA1[8 * s2 + 3]); b_.z = cvt_pk_bf16(PA1[8 * s2 + 4], PA1[8 * s2 + 5]); b_.w = cvt_pk_bf16(PA1[8 * s2 + 6], PA1[8 * s2 + 7]); \
      pf_[s2] = __builtin_bit_cast(bf16x8, a_); pf_[2 + s2] = __builtin_bit_cast(bf16x8, b_); } \
    SB(); \
    VFRAG(vfb_, sl_, 1); \
    _Pragma("unroll") for (int q_ = 0; q_ < 4; ++q_) o[0] = MFMA32(__builtin_bit_cast(bf16x8, vfa_[q_]), pf_[q_], o[0]); \
    SB(); \
    VFRAG(vfa_, sl_, 2); \
    _Pragma("unroll") for (int q_ = 0; q_ < 4; ++q_) o[1] = MFMA32(__builtin_bit_cast(bf16x8, vfb_[q_]), pf_[q_], o[1]); \
    SB(); \
    VFRAG(vfb_, sl_, 3); \
    _Pragma("unroll") for (int q_ = 0; q_ < 4; ++q_) o[2] = MFMA32(__builtin_bit_cast(bf16x8, vfa_[q_]), pf_[q_], o[2]); \
    float mx = 0.f; \
    if (HAS_NEXT) { mx = PB0[0]; \
      _Pragma("unroll") for (int i = 1; i < 16; ++i) mx = __builtin_fmaxf(mx, PB0[i]); \
      _Pragma("unroll") for (int i = 0; i < 16; ++i) mx = __builtin_fmaxf(mx, PB1[i]); } \
    SB(); \
    _Pragma("unroll") for (int q_ = 0; q_ < 4; ++q_) o[3] = MFMA32(__builtin_bit_cast(bf16x8, vfb_[q_]), pf_[q_], o[3]); \
    if (HAS_NEXT) { \
      mx = pl32_max(mx); \
      if (__any(mx > 8.0f)) { const float mn_ = __uint_as_float(cvt_pk_bf16(m_run + fmaxf(mx, 0.f), 0.f) << 16); const float dl = mn_ - m_run; m_run = mn_; const float al = __builtin_amdgcn_exp2f(-dl); lsum *= al; \
        _Pragma("unroll") for (int i = 0; i < 16; ++i) { PB0[i] -= dl; PB1[i] -= dl; } \
        _Pragma("unroll") for (int v = 0; v < 4; ++v) _Pragma("unroll") for (int i = 0; i < 16; ++i) o[v][i] *= al; } \
      } \
    if ((t) + 3 < NT) ST_K((sl_ + 3) & 3); if ((t) + 2 < NT) ST_V((sl_ + 2) & 3); \
    if (DO_BAR) __syncthreads(); } while (0)
  for (int t = 0; t < NT - 2; t += 2) { BODY(pA0, pA1, pB0, pB1, t, true, false); BODY(pB0, pB1, pA0, pA1, t + 1, true, true); }
  BODY(pA0, pA1, pB0, pB1, NT - 2, true, false); BODY(pB0, pB1, pA0, pA1, NT - 1, false, true);
#undef BODY
#undef VFRAG
#undef SB
#undef QK
#undef LD_K
#undef LD_V
#undef ST_K
#undef ST_V
#undef KSLOT
#undef VSLOT
  const float lam = __int_as_float(lam_bits), oml = 1.0f - __int_as_float(lami_bits);
  u32x4 zw_[4];
  { const bf16_t* zp_ = ZA + (rowbase + q0 + (tid >> 2)) * 1024 + head * 128 + (tid & 3) * 32;
#pragma unroll
    for (int j = 0; j < 4; ++j) zw_[j] = *(const u32x4*)(zp_ + j * 8); }
  const float ltot = pl32_sum(lsum); const float inv = 1.0f / ltot;
  LAS float* EX = (LAS float*)lds;
  if (map == 1) { const float sc = lam * inv;
#pragma unroll
    for (int v = 0; v < 4; ++v)
#pragma unroll
      for (int i = 0; i < 16; ++i) EX[(qw * 32 + r) * EXSTR + v * 32 + crow(i, hh)] = o[v][i] * sc; }
  __syncthreads();
  if (map == 0) { float ss = 0.f;
#pragma unroll
    for (int v = 0; v < 4; ++v)
#pragma unroll
      for (int i = 0; i < 16; ++i) { const float d = o[v][i] * inv - EX[(qw * 32 + r) * EXSTR + v * 32 + crow(i, hh)]; o[v][i] = d; ss += d * d; }
    ss = pl32_sum(ss);
    const float rstd = __builtin_amdgcn_rsqf(ss * (1.0f / 128.0f) + 1e-5f) * oml;
    LAS bf16_t* YT = (LAS bf16_t*)(lds + YT_OFF);
#pragma unroll
    for (int v = 0; v < 4; ++v)
#pragma unroll
      for (int i = 0; i < 16; ++i) { const int vd = v * 32 + crow(i, hh); const float y = o[v][i] * rstd * subw[vd]; YT[(qw * 32 + r) * (YTSTR / 2) + vd] = (bf16_t)(cvt_pk_bf16(y, 0.f) & 0xffffu); } }
  __syncthreads();
  { const int q = tid >> 2, seg = tid & 3; const size_t row = rowbase + q0 + q;
    bf16_t* op = ACAT + row * 3072 + head * 128 + seg * 32;
#pragma unroll
    for (int j = 0; j < 4; ++j) {
      const u32x4 yw = *(const LAS u32x4*)(lds + YT_OFF + q * YTSTR + seg * 64 + j * 16);
      const u32x4 zw = zw_[j]; const f32x4 z0 = {bf_lo(zw.x), bf_hi(zw.x), bf_lo(zw.y), bf_hi(zw.y)}, z1 = {bf_lo(zw.z), bf_hi(zw.z), bf_lo(zw.w), bf_hi(zw.w)};
      const f32x4 y0 = {bf_lo(yw.x), bf_hi(yw.x), bf_lo(yw.y), bf_hi(yw.y)}, y1 = {bf_lo(yw.z), bf_hi(yw.z), bf_lo(yw.w), bf_hi(yw.w)};
      st8(op + j * 8, y0 * z0, y1 * z1);
    } }
  __syncthreads();
}
}

__device__ __forceinline__ void norm_phase(int wv, const float* xlat, float* xctx, const float* px  , const float* pgate, const float* normw, const float* mod  , bf16_t* HN, bf16_t* SBL, bf16_t* SBC, int chunk, int r0 = 0, int r1 = RC, int wcu = -1, int ncu = 0) {
  const int tid_ = fresh_tid(wv), lane = tid_ & 63, gw = (wcu < 0 ? (int)blockIdx.x : wcu) * 8 + wv, NGW = (wcu < 0 ? (int)gridDim.x : ncu) * 8;
  for (int rr = r0 + gw; rr < r1; rr += NGW) {
    const int bl = rr / TB, j = rr % TB, b = chunk * CB + bl; const bool ctx = j >= SEQ;
    const float* xr = ctx ? (const float*)xctx + ((size_t)b * CTXL + (j - SEQ)) * 1024 : xlat + ((size_t)b * SEQ + j) * 1024;
    const float* md = mod + (size_t)(ctx ? 16 : b) * 3072;
    const int jc = ctx ? j - SEQ : j, nn = ctx ? CTXL : SEQ; const int sr = (jc == nn / 2) ? 0 : (jc > nn - 128 ? nn - jc : -1);
    bf16_t* sb = ctx ? SBC : SBL;
    f32x4 v[4]; float s = 0.f;
#pragma unroll
    for (int q = 0; q < 4; ++q) { v[q] = *(const f32x4*)(xr + 4 * lane + 256 * q);
      if (ctx && px) {
        const size_t po = ((size_t)bl * CTXL + (j - SEQ)) * 1024 + 4 * lane + 256 * q;
        const f32x4 pp = (*(const f32x4*)(px + po) + *(const f32x4*)(px + (size_t)2048 * 1024 + po)) + *(const f32x4*)(px + (size_t)2 * 2048 * 1024 + po);
        v[q] = v[q] + *(const f32x4*)(pgate + 4 * lane + 256 * q) * pp;
        *(f32x4*)(xctx + ((size_t)b * CTXL + (j - SEQ)) * 1024 + 4 * lane + 256 * q) = v[q]; }
      s += (v[q][0] * v[q][0] + v[q][1] * v[q][1]) + (v[q][2] * v[q][2] + v[q][3] * v[q][3]); }
    const float rstd = __builtin_amdgcn_rsqf(wave_sum(s, lane) * (1.0f / 1024.0f) + 1e-6f);
#pragma unroll
    for (int q = 0; q < 4; ++q) {
      const int c = 4 * lane + 256 * q;
      const f32x4 nw = *(const f32x4*)(normw + c), sh = *(const f32x4*)(md + c), sc = *(const f32x4*)(md + 1024 + c);
      const f32x4 y = (v[q] * rstd) * nw * (sc + 1.0f) + sh;
      u32x2 wv; wv.x = cvt_pk_bf16(y[0], y[1]); wv.y = cvt_pk_bf16(y[2], y[3]);
      *(u32x2*)(HN + (size_t)rr * 1024 + c) = wv;
      if (sr >= 0) *(u32x2*)(sb + ((size_t)bl * 128 + 127 - sr) * 1024 + c) = wv;
    }
  }
}
__device__ __forceinline__ void conv_phase(int wv, const bf16_t* U, const bf16_t* BZ, const float* cw  , bf16_t* ACAT) {
  const int tid_ = fresh_tid(wv), lane = tid_ & 63, gw = blockIdx.x * 8 + wv, NGW = gridDim.x * 8;
  for (int it = gw; it < (RC / 4) * 2; it += NGW) {
    const int q = it & 1, r0 = (it >> 1) * 4, j0 = r0 % TB, c = lane * 8 + 512 * q;
    const bool hp = !(j0 == 0 || j0 == SEQ), hn = !(j0 + 3 == SEQ - 1 || j0 + 3 == TB - 1);
    u32x4 uw[6], zw[4];
    uw[0] = hp ? *(const u32x4*)(U + (size_t)(r0 - 1) * 1024 + c) : (u32x4){0u, 0u, 0u, 0u};
#pragma unroll
    for (int k = 0; k < 4; ++k) { uw[1 + k] = *(const u32x4*)(U + (size_t)(r0 + k) * 1024 + c); zw[k] = *(const u32x4*)(BZ + (size_t)(r0 + k) * 1024 + c); }
    uw[5] = hn ? *(const u32x4*)(U + (size_t)(r0 + 4) * 1024 + c) : (u32x4){0u, 0u, 0u, 0u};
    const f32x4 w00 = *(const f32x4*)(cw + c), w01 = *(const f32x4*)(cw + c + 4), w10 = *(const f32x4*)(cw + 1024 + c), w11 = *(const f32x4*)(cw + 1024 + c + 4), w20 = *(const f32x4*)(cw + 2048 + c), w21 = *(const f32x4*)(cw + 2048 + c + 4);
#pragma unroll
    for (int k = 0; k < 4; ++k) {
      const u32x4 a = uw[k], b = uw[k + 1], d = uw[k + 2], z = zw[k];
      const f32x4 a0 = {bf_lo(a.x), bf_hi(a.x), bf_lo(a.y), bf_hi(a.y)}, a1 = {bf_lo(a.z), bf_hi(a.z), bf_lo(a.w), bf_hi(a.w)};
      const f32x4 b0 = {bf_lo(b.x), bf_hi(b.x), bf_lo(b.y), bf_hi(b.y)}, b1 = {bf_lo(b.z), bf_hi(b.z), bf_lo(b.w), bf_hi(b.w)};
      const f32x4 d0 = {bf_lo(d.x), bf_hi(d.x), bf_lo(d.y), bf_hi(d.y)}, d1 = {bf_lo(d.z), bf_hi(d.z), bf_lo(d.w), bf_hi(d.w)};
      const f32x4 z0 = {bf_lo(z.x), bf_hi(z.x), bf_lo(z.y), bf_hi(z.y)}, z1 = {bf_lo(z.z), bf_hi(z.z), bf_lo(z.w), bf_hi(z.w)};
      st8(ACAT + (size_t)(r0 + k) * 3072 + 1024 + c, (w00 * a0 + w10 * b0 + w20 * d0) * z0, (w01 * a1 + w11 * b1 + w21 * d1) * z1);
    }
  }
}
__device__ __forceinline__ void final_norm(int wv, float* x, const float* w) {
  const int tid_ = fresh_tid(wv), lane = tid_ & 63, gw = blockIdx.x * 8 + wv, NGW = gridDim.x * 8;
  for (int rr0 = gw; rr0 < NBATCH * SEQ; rr0 += 4 * NGW) {
    f32x4 v[4][4];
#pragma unroll
    for (int u = 0; u < 4; ++u) if (rr0 + u * NGW < NBATCH * SEQ) {
#pragma unroll
      for (int q = 0; q < 4; ++q) v[u][q] = *(const f32x4*)(x + (size_t)(rr0 + u * NGW) * 1024 + 4 * lane + 256 * q); }
#pragma unroll
    for (int u = 0; u < 4; ++u) if (rr0 + u * NGW < NBATCH * SEQ) {
      float* xr = x + (size_t)(rr0 + u * NGW) * 1024; float s = 0.f;
#pragma unroll
      for (int q = 0; q < 4; ++q) s += (v[u][q][0] * v[u][q][0] + v[u][q][1] * v[u][q][1]) + (v[u][q][2] * v[u][q][2] + v[u][q][3] * v[u][q][3]);
      const float rstd = __builtin_amdgcn_rsqf(wave_sum(s, lane) * (1.0f / 1024.0f) + 1e-6f);
#pragma unroll
      for (int q = 0; q < 4; ++q) { const int c = 4 * lane + 256 * q; *(f32x4*)(xr + c) = (v[u][q] * rstd) * *(const f32x4*)(w + c); }
    }
  }
}
__device__ __forceinline__ void transpose_item(const float* __restrict__ W, int ldw, bf16_t* dst, int ldo, LAS float* scr, int lane, bool rperm = false) {
#pragma unroll 8
  for (int i = 0; i < 32; ++i) { const int kk = 2 * i + (lane >> 5); scr[kk * 33 + (lane & 31)] = W[(size_t)kk * ldw + (lane & 31)]; }
  asm volatile("s_waitcnt lgkmcnt(0)" ::: "memory");
  const int c = lane & 7;
#pragma unroll
  for (int j = 0; j < 4; ++j) { const int n = (lane >> 3) + 8 * j; const LAS float* s = scr + (8 * c) * 33 + n;
    const int nd = rperm ? (((n & 15) >> 2) * 8 + ((n >> 4) << 2) + (n & 3)) : n;
    u32x4 o; o.x = cvt_pk_bf16(s[0 * 33], s[1 * 33]); o.y = cvt_pk_bf16(s[2 * 33], s[3 * 33]); o.z = cvt_pk_bf16(s[4 * 33], s[5 * 33]); o.w = cvt_pk_bf16(s[6 * 33], s[7 * 33]);
    *(u32x4*)(dst + (size_t)nd * ldo + 8 * c) = o; }
  asm volatile("s_waitcnt lgkmcnt(0)" ::: "memory");
}
__device__ __forceinline__ int win_dest_row(int n0) {
  const int seg = n0 >> 10, off = n0 & 1023;
  switch (seg) {
    case 0: return off;
    case 1: return 1024 + off;
    case 2: return -1 - off;
    case 3: return 2048 + off;
    case 4: return 3072 + (off >> 7) * 256 + (off & 127);
    case 6: return 3072 + (off >> 7) * 256 + 128 + (off & 127);
    case 5: return 5120 + (off >> 7) * 256 + (off & 127);
    case 7: return 5120 + (off >> 7) * 256 + 128 + (off & 127);
    case 8: return -100000;
    case 9: return 7168 + off;
    default: return 8192 + (n0 - 10240);
  }
}

#define WS_PTRS(w_) \
  float* MOD = (float*)((w_) + WS_MOD); float* ROPEC = (float*)((w_) + WS_ROPEC); float* ROPES = (float*)((w_) + WS_ROPES); float* LAM = (float*)((w_) + WS_LAM); \
  float* XC = (float*)((w_) + WS_XC); bf16_t* DFT = (bf16_t*)((w_) + WS_DFT); bf16_t* DFTC = (bf16_t*)((w_) + WS_DFTC); \
  bf16_t* HN = (bf16_t*)((w_) + WS_HN); bf16_t* QB = (bf16_t*)((w_) + WS_QB); bf16_t* KB = (bf16_t*)((w_) + WS_KB); bf16_t* ZA = (bf16_t*)((w_) + WS_ZA); \
  bf16_t* U = (bf16_t*)((w_) + WS_U); bf16_t* BZ = (bf16_t*)((w_) + WS_BZ); bf16_t* ZF = (bf16_t*)((w_) + WS_ZF); bf16_t* VT = (bf16_t*)((w_) + WS_VT); \
  bf16_t* YG = (bf16_t*)((w_) + WS_YG); bf16_t* GT = (bf16_t*)((w_) + WS_GT); bf16_t* HT = (bf16_t*)((w_) + WS_HT); bf16_t* HTC = (bf16_t*)((w_) + WS_HTC); bf16_t* ACAT = (bf16_t*)((w_) + WS_ACAT); \
  (void)0

struct Args { const float* in[16]; float* out; unsigned char* ws; float lam_init[4]; int pad[2]; };

__global__ void __launch_bounds__(512, 2) fwd_megakernel(Args args) {
  extern __shared__ __attribute__((aligned(16))) unsigned char lds_raw[];
  LAS unsigned char* lds = (LAS unsigned char*)lds_raw;
  cg::grid_group grid = cg::this_grid();
  const int G = gridDim.x, bx = blockIdx.x;
  const int wv = __builtin_amdgcn_readfirstlane((int)(threadIdx.x >> 6));
  volatile LAS unsigned* bst = (volatile LAS unsigned*)(lds + 147456 - 128);
  if (threadIdx.x < 2) bst[threadIdx.x] = 0u;
  __syncthreads();
  XcdBarrier xbar; xbar.bar = (unsigned*)(args.ws + WS_BAR); xbar.x = xb_xcc_id(); xbar.st = bst;
  if (blockIdx.x == 0) { for (int i_ = threadIdx.x; i_ < XCD_BAR_WORDS; i_ += 512) xbar.bar[i_] = 0u; }
  unsigned char* ws = args.ws; float* OUT = args.out;
  const float* x_in = args.in[0]; const float* c_in = args.in[1]; const float* ctx_in = args.in[2]; const float* cctx_in = args.in[3];
  const float* norm_w = args.in[4]; const float* w_mod = args.in[5]; const float* b_mod = args.in[6]; const float* w_in = args.in[7];
  const float* lambda_qk = args.in[8]; const float* subln_w = args.in[9]; const float* conv_w = args.in[10];
  const float* w_ao = args.in[11]; const float* w_co = args.in[12]; const float* w_fo = args.in[13]; const float* w_out = args.in[14]; const float* final_w = args.in[15];

  {
  WS_PTRS(ws);
  const int tid = fresh_tid(wv), lane = tid & 63, wave = wv, gw = bx * 8 + wave, NGW = G * 8;
  {
    LAS float* scr = (LAS float*)(lds + wave * 8448);
    constexpr int I_IN = 16 * 416, I_SQ = 16 * 32, PER_L = I_IN + 4 * I_SQ;
    for (int it = gw; it < DEPTH * PER_L; it += NGW) {
      const int l = it / PER_L; int r = it % PER_L;
      unsigned char* wl = ws + WS_W + (size_t)l * W_LAYER;
      if (r < I_IN) {
        const int kb = r / 416, nb = r % 416, n0 = nb * 32, k0 = kb * 64; const int dr = win_dest_row(n0);
        if (dr == -100000) continue;
        bf16_t* dst = dr >= 0 ? (bf16_t*)(wl + W_T1) + (size_t)dr * 1024 + k0 : (bf16_t*)(wl + W_T2) + (size_t)(-1 - dr) * 1024 + k0;
        transpose_item(w_in + ((size_t)l * 1024 + k0) * PROJW + n0, PROJW, dst, 1024, scr, lane, n0 < 2048);
      } else {
        r -= I_IN; const int mi = r / I_SQ, q = r % I_SQ, kb = q / 32, nb = q % 32, n0 = nb * 32, k0 = kb * 64;
        const float* src = (mi == 0 ? w_ao : mi == 1 ? w_co : mi == 2 ? w_fo : w_out) + ((size_t)l * 1024 + k0) * 1024 + n0;
        if (mi < 3) transpose_item(src, 1024, (bf16_t*)(wl + W_CAT) + (size_t)(mi * 1024 + n0) * 1024 + k0, 1024, scr, lane);
        else {
#pragma unroll 1
          for (int rep = 0; rep < 3; ++rep) transpose_item(src, 1024, (bf16_t*)(wl + W_O3) + (size_t)n0 * 3072 + rep * 1024 + k0, 3072, scr, lane);
        }
      }
    }
  }
  __syncthreads();
  {
    LAS float* Wl = (LAS float*)lds; LAS float* tabc = (LAS float*)(lds + 64 * 132 * 4); LAS float* tabs = tabc + 128;
    for (int item = bx; item < 512; item += G) {
      const int l = item >> 7, g = (item >> 4) & 7, kb = item & 15;
      const float* W = w_in + ((size_t)l * 1024 + kb * 64) * PROJW + 8192 + g * 128;
      __syncthreads();
#pragma unroll
      for (int i = 0; i < 4; ++i) { const int idx = tid + 512 * i, row = idx >> 5, c4 = idx & 31; *(LAS f32x4*)(Wl + row * 132 + c4 * 4) = *(const f32x4*)(W + (size_t)row * PROJW + c4 * 4); }
      if (tid < 128) { const float ph = (float)tid * (1.0f / 128.0f); tabc[tid] = __builtin_amdgcn_cosf(ph) * 0.08838834764831845f; tabs[tid] = __builtin_amdgcn_sinf(ph) * 0.08838834764831845f; }
      __syncthreads();
      const int s = tid >> 2, kq = tid & 3, part = s > 64, k2 = part ? s - 64 : s;
      const LAS float* tab = part ? tabs : tabc;
      float acc[16];
#pragma unroll
      for (int k = 0; k < 16; ++k) acc[k] = 0.f;
#pragma unroll 1
      for (int j4 = 0; j4 < 32; ++j4) {
        const float c0 = tab[((4 * j4 + 0) * k2) & 127], c1 = tab[((4 * j4 + 1) * k2) & 127], c2 = tab[((4 * j4 + 2) * k2) & 127], c3 = tab[((4 * j4 + 3) * k2) & 127];
#pragma unroll
        for (int k = 0; k < 16; ++k) { const f32x4 w4 = *(const LAS f32x4*)(Wl + (kq * 16 + k) * 132 + 4 * j4); acc[k] += (w4[0] * c0 + w4[1] * c1) + (w4[2] * c2 + w4[3] * c3); }
      }
      bf16_t* dst = (bf16_t*)(ws + WS_W + (size_t)l * W_LAYER + W_T2) + (size_t)(1024 + g * 128 + s) * 1024 + kb * 64 + kq * 16;
#pragma unroll
      for (int q = 0; q < 2; ++q) { u32x4 o; o.x = cvt_pk_bf16(acc[8 * q + 0], acc[8 * q + 1]); o.y = cvt_pk_bf16(acc[8 * q + 2], acc[8 * q + 3]); o.z = cvt_pk_bf16(acc[8 * q + 4], acc[8 * q + 5]); o.w = cvt_pk_bf16(acc[8 * q + 6], acc[8 * q + 7]); *(u32x4*)(dst + 8 * q) = o; }
    }
  }
  __syncthreads();
  {
    const int gt = bx * 512 + tid, NGT = G * 512;
    for (int item = gt; item < 2048 * 256; item += NGT) {
      const int k1 = item >> 8, j0 = (item & 255) * 8; float v[8];
#pragma unroll
      for (int e = 0; e < 8; ++e) { const int j = j0 + e; const bool sn = j >= 1024; const float ph = (float)((k1 * (j & 1023)) & 2047) * (1.0f / 2048.0f);
        v[e] = (sn ? -__builtin_amdgcn_sinf(ph) : __builtin_amdgcn_cosf(ph)) * 0.022097086912079608f; }
      u32x4 o; o.x = cvt_pk_bf16(v[0], v[1]); o.y = cvt_pk_bf16(v[2], v[3]); o.z = cvt_pk_bf16(v[4], v[5]); o.w = cvt_pk_bf16(v[6], v[7]);
      *(u32x4*)(DFT + (size_t)k1 * 2048 + j0) = o;
    }
    for (int item = gt; item < 256 * 32; item += NGT) {
      const int k1 = item >> 5, j0 = (item & 31) * 8; float v[8];
#pragma unroll
      for (int e = 0; e < 8; ++e) { const int j = j0 + e; const bool sn = j >= 128; const float ph = (float)((k1 * (j & 127)) & 255) * (1.0f / 256.0f);
        v[e] = (sn ? -__builtin_amdgcn_sinf(ph) : __builtin_amdgcn_cosf(ph)) * 0.0625f; }
      u32x4 o; o.x = cvt_pk_bf16(v[0], v[1]); o.y = cvt_pk_bf16(v[2], v[3]); o.z = cvt_pk_bf16(v[4], v[5]); o.w = cvt_pk_bf16(v[6], v[7]);
      *(u32x4*)(DFTC + (size_t)k1 * 256 + j0) = o;
    }
    for (int item = gt; item < NBATCH * CTXL * 256; item += NGT) *(f32x4*)(XC + (size_t)item * 4) = *(const f32x4*)(ctx_in + (size_t)item * 4);
    if (gt < 1024) { const int p = gt >> 4, i = gt & 15; const float inv = __builtin_amdgcn_exp2f(-(float)i * (13.287712379549449f / 16.0f)); const float a = (float)p * inv;
      ROPEC[gt] = __builtin_amdgcn_cosf(a * 0.15915494309189535f); ROPES[gt] = __builtin_amdgcn_sinf(a * 0.15915494309189535f); }
    if (gt < DEPTH) { const float* lq = lambda_qk + gt * 256; float s1 = 0.f, s2 = 0.f;
      for (int i = 0; i < 64; ++i) { s1 += lq[i] * lq[64 + i]; s2 += lq[128 + i] * lq[192 + i]; }
      LAM[gt] = __builtin_amdgcn_exp2f(s1 * LOG2E) - __builtin_amdgcn_exp2f(s2 * LOG2E) + args.lam_init[gt]; }
  }
  {
    LAS float* sl = (LAS float*)lds; LAS float* red = (LAS float*)(lds + 17 * 1024 * 4);
    if (bx < 192) {
      for (int idx = tid; idx < 17 * 1024; idx += 512) { const int r = idx >> 10, k = idx & 1023; const float xv = (r < 16) ? c_in[r * 1024 + k] : cctx_in[k]; sl[idx] = xv * fast_sigmoid(xv); }
      __syncthreads();
      for (int item = bx; item < 192; item += G) {
        const int l = item / 48, cb = item % 48, cc = tid & 63, ks = tid >> 6;
        float acc[17];
#pragma unroll
        for (int r = 0; r < 17; ++r) acc[r] = 0.f;
        const float* wp = w_mod + ((size_t)l * 1024 + ks * 128) * 3072 + cb * 64 + cc;
#pragma unroll 4
        for (int k = 0; k < 128; ++k) { const float wv = wp[(size_t)k * 3072];
#pragma unroll
          for (int r = 0; r < 17; ++r) acc[r] += sl[r * 1024 + ks * 128 + k] * wv; }
#pragma unroll
        for (int r = 0; r < 17; ++r) red[(ks * 17 + r) * 64 + cc] = acc[r];
        __syncthreads();
        for (int idx = tid; idx < 17 * 64; idx += 512) { const int r = idx >> 6, c2 = idx & 63; float s = 0.f;
#pragma unroll
          for (int k8 = 0; k8 < 8; ++k8) s += red[(k8 * 17 + r) * 64 + c2];
          MOD[((size_t)l * 17 + r) * 3072 + cb * 64 + c2] = s + b_mod[l * 3072 + cb * 64 + c2]; }
        __syncthreads();
      }
    }
  }
  }
  grid.sync();
  if (threadIdx.x == 0) (void)xb_add(&xbar.bar[XB_XCNT(xbar.x)], 1u);
  { unsigned char* w_ = fresh_ptr(ws); WS_PTRS(w_); norm_phase(wv, x_in, XC, nullptr, nullptr, norm_w, MOD, HN, (bf16_t*)(w_ + WS_SBL), (bf16_t*)(w_ + WS_SBC), 0); }
  xcd_barrier(xbar, wv);

#pragma unroll 1
  for (int step = 0; step < DEPTH * NCH; ++step) {
    const int l = step >> 1, ch = step & 1;
    int bxl = blockIdx.x, Gl = gridDim.x; asm volatile("" : "+s"(bxl), "+s"(Gl));
    { unsigned char* w_ = fresh_ptr(ws); WS_PTRS(w_); unsigned char* wl = w_ + WS_W + (size_t)l * W_LAYER;
      pg8::Gemm g{1024, 1024, 1024};
      const int lastl = (l == DEPTH - 1);
      PlainOrder S; S.init2(HN, wl + W_T1, lastl ? CB * SEQ : RC, N1, 1024, 1024, Gl, bxl, 1 << 30, 0, lastl ? 2 : 0);
      EpiMain E{QB, KB, ZA, U, BZ, ZF, GT, ROPEC, ROPES};
      pg8::gemm_phase<EpiMain, PlainOrder>(wv, lds, g, S, E);
      PlainOrder S2; S2.init2(wl + W_T2, HN, 1024, RC, 1024, 1024, Gl, (bxl + Gl - 96) % Gl);
      EpiT E2{VT, HT, HTC};
      pg8::gemm_phase<EpiT, PlainOrder>(wv, lds, g, S2, E2);
      MirrorOrder S3{Gl, (bxl + Gl - 128) % Gl, (const char*)(wl + W_T2), (const char*)HN, (const char*)(w_ + WS_SBL), (const char*)(w_ + WS_SBC)};
      EpiT2 E3{HT, HTC, (float*)(w_ + WS_NYQ), (float*)(w_ + WS_NYQC)};
      pg8::gemm_phase<EpiT2, MirrorOrder>(wv, lds, g, S3, E3);
      if (step > 0)
      { const int lp_ = ((step - 1) >> 1), chp_ = ((step - 1) & 1); unsigned char* wlp = w_ + WS_W + (size_t)lp_ * W_LAYER;
        pg8::Gemm g5{1024, 3072, 1024};
        PlainOrder S5; S5.init2(w_ + WS_MRG, wlp + W_O3, CB * SEQ, 1024, 1024, 3072, Gl, (bxl + Gl - 160) % Gl, 1 << 30, 0, 1);
        EpiRes E5{lp_ == 0 ? x_in : OUT, XC, OUT, XC, MOD + (size_t)lp_ * 17 * 3072, chp_};
        pg8::gemm_phase<EpiRes, PlainOrder>(wv, lds, g5, S5, E5);
        if (lp_ < DEPTH - 1) {
          pg8::Gemm gc{3072, 3072, 1024};
          CtxOrder SC{Gl, (bxl + Gl - 160) % Gl, (const char*)(w_ + WS_YGC), (const char*)(wlp + W_O3), (size_t)256 * 3072 * 2, (size_t)256 * 3072 * 2, 1, 0};
          EpiPart EC{(float*)(w_ + WS_PX) + (size_t)chp_ * 3 * 2048 * 1024};
          pg8::gemm_phase<EpiPart, CtxOrder>(wv, lds, gc, SC, EC); } }
    }
    xcd_barrier(xbar, wv);
    { unsigned char* w_ = fresh_ptr(ws); WS_PTRS(w_); const int lam = __builtin_amdgcn_readfirstlane(__float_as_int(LAM[l])), oml = __builtin_amdgcn_readfirstlane(__float_as_int(args.lam_init[l]));
      const float* subw = subln_w + l * 128;
      for (int i_ = 0;; ++i_) { int bh, qb; int G_ = Gl; asm volatile("" : "+s"(G_));
        if (G_ == 256) { if (i_ >= (CB * NHEAD * 16) / 256) break; const int xj_ = bxl >> 3; bh = i_ * 16 + (bxl & 7) * 2 + (xj_ >> 4); qb = xj_ & 15; }
        else { const int uidx = i_ * Gl + bxl; if (uidx >= CB * NHEAD * 16) break; bh = uidx >> 4; qb = uidx & 15; }
        att::attn_unit(wv, lds, QB, KB, VT, ZA, ACAT, bh >> 3, bh & 7, qb * 128, 0, TB, lam, oml, subw); }
      if (l < DEPTH - 1) for (int uidx = bxl; uidx < CB * NHEAD * 2; uidx += Gl) { const int bh = uidx >> 1, qb = uidx & 1;
        att::attn_unit(wv, lds, QB, KB, VT, ZA, ACAT, bh >> 3, bh & 7, SEQ + qb * 128, SEQ, CTXL, lam, oml, subw); }
      EpiFour EF{ACAT, ZF, (const float*)(w_ + WS_NYQ), (const float*)(w_ + WS_NYQC)};
      { pg8::Gemm g{2048, 2048, 2048}; BatchOrder S{CB, 8, 4, Gl, (bxl + Gl - 128) % Gl, 0, (const char*)DFT, (const char*)HT, (size_t)256 * 2048 * 2, (size_t)1024 * 2048 * 2, (size_t)256 * 2048 * 2};
        pg8::gemm_phase<EpiFour, BatchOrder>(wv, lds, g, S, EF); }
      if (l < DEPTH - 1) { pg8::Gemm g{256, 256, 256}; BatchOrder S{CB, 1, 4, Gl, (bxl + Gl - 128) % Gl, 8, (const char*)DFTC, (const char*)HTC, 0, (size_t)1024 * 256 * 2, (size_t)256 * 256 * 2};
        pg8::gemm_phase<EpiFour, BatchOrder>(wv, lds, g, S, EF); }
      conv_phase(wv, U, BZ, conv_w + l * 3072, ACAT); }
    xcd_barrier(xbar, wv);
    { unsigned char* w_ = fresh_ptr(ws); WS_PTRS(w_); unsigned char* wl = w_ + WS_W + (size_t)l * W_LAYER;
      pg8::Gemm g{3072, 1024, 1024};
      const int lastl = (l == DEPTH - 1);
      TripleOrder S; S.so.init(ACAT, wl + W_CAT, CB * SEQ, 1024, 3072, 1024, Gl, bxl); S.W = (const char*)(wl + W_CAT); S.lat = 1;
      EpiAcc E{(bf16_t*)(w_ + WS_MRG), GT, (float*)(w_ + WS_SCR) + (size_t)bxl * 65536};
      pg8::gemm_phase<EpiAcc, TripleOrder>(wv, lds, g, S, E);
      if (!lastl) {
        CtxOrder SC{Gl, bxl, (const char*)ACAT, (const char*)(wl + W_CAT), (size_t)256 * 3072 * 2, (size_t)256 * 1024 * 2, 0, 1};
        EpiMulBf16 EC{(bf16_t*)(w_ + WS_YGC), GT, 3072, 3072, 0, 0, 1};
        pg8::gemm_phase<EpiMulBf16, CtxOrder>(wv, lds, g, SC, EC);
      }
      if (step + 1 < DEPTH * NCH) {
        const int l2 = (step + 1) >> 1, ch2 = (step + 1) & 1;
        const float* px2 = l2 == 0 ? nullptr : (const float*)(w_ + WS_PX) + (size_t)ch2 * 3 * 2048 * 1024; const float* pg2 = l2 == 0 ? nullptr : MOD + (size_t)(l2 - 1) * 17 * 3072 + 16 * 3072 + 2048;
        if (Gl == 256 && !lastl) { if (bxl >= 96) norm_phase(wv, l2 == 0 ? x_in : OUT, XC, px2, pg2, norm_w + l2 * 1024, MOD + (size_t)l2 * 17 * 3072, HN, (bf16_t*)(w_ + WS_SBL), (bf16_t*)(w_ + WS_SBC), ch2, 0, RC, bxl - 96, 160); }
        else norm_phase(wv, l2 == 0 ? x_in : OUT, XC, px2, pg2, norm_w + l2 * 1024, MOD + (size_t)l2 * 17 * 3072, HN, (bf16_t*)(w_ + WS_SBL), (bf16_t*)(w_ + WS_SBC), ch2); } }
    xcd_barrier(xbar, wv);
  }
  { unsigned char* w_ = fresh_ptr(ws); WS_PTRS(w_); int bxl = blockIdx.x, Gl = gridDim.x; asm volatile("" : "+s"(bxl), "+s"(Gl));
      { const int lp_ = (DEPTH - 1), chp_ = (NCH - 1); unsigned char* wlp = w_ + WS_W + (size_t)lp_ * W_LAYER;
        pg8::Gemm g5{1024, 3072, 1024};
        PlainOrder S5; S5.init2(w_ + WS_MRG, wlp + W_O3, CB * SEQ, 1024, 1024, 3072, Gl, (bxl + Gl - 160) % Gl, 1 << 30, 0, 1);
        EpiRes E5{lp_ == 0 ? x_in : OUT, XC, OUT, XC, MOD + (size_t)lp_ * 17 * 3072, chp_};
        pg8::gemm_phase<EpiRes, PlainOrder>(wv, lds, g5, S5, E5);
        if (lp_ < DEPTH - 1) {
          pg8::Gemm gc{3072, 3072, 1024};
          CtxOrder SC{Gl, (bxl + Gl - 160) % Gl, (const char*)(w_ + WS_YGC), (const char*)(wlp + W_O3), (size_t)256 * 3072 * 2, (size_t)256 * 3072 * 2, 1, 0};
          EpiPart EC{(float*)(w_ + WS_PX) + (size_t)chp_ * 3 * 2048 * 1024};
          pg8::gemm_phase<EpiPart, CtxOrder>(wv, lds, gc, SC, EC); } }
  }
  xcd_barrier(xbar, wv);
  final_norm(wv, args.out, final_w);
}

extern "C" void kernel_launch(void* const* d_in, const int* in_sizes, int n_in, void* d_out, int out_size, void* d_ws, size_t ws_size, hipStream_t stream) {
  static int grid = 0;
  constexpr int LDS_BYTES = 147456;
  if (grid == 0) {
    if (n_in != 16 || out_size != NBATCH * SEQ * D || ws_size < WS_END) { fprintf(stderr, "kernel_launch: unexpected shapes / workspace (%d inputs, out %d, ws %zu)\n", n_in, out_size, ws_size); grid = -1; return; }
    int dev = 0, cus = 0, per_cu = 0;
    (void)hipGetDevice(&dev); (void)hipDeviceGetAttribute(&cus, hipDeviceAttributeMultiprocessorCount, dev);
    (void)hipFuncSetAttribute((const void*)fwd_megakernel, hipFuncAttributeMaxDynamicSharedMemorySize, LDS_BYTES);
    (void)hipOccupancyMaxActiveBlocksPerMultiprocessor(&per_cu, (const void*)fwd_megakernel, 512, LDS_BYTES);
    if (per_cu < 1) { fprintf(stderr, "kernel_launch: occupancy query says %d blocks per CU\n", per_cu); per_cu = 1; }
    grid = cus;
    if (grid % 8 != 0 || grid < 200) fprintf(stderr, "kernel_launch: unexpected CU count %d\n", cus);
  }
  if (grid < 0) return;
  Args a{};
  for (int i = 0; i < 16; ++i) a.in[i] = (const float*)d_in[i];
  a.out = (float*)d_out; a.ws = (unsigned char*)d_ws;
  const double li[4] = {0.8 - 0.6 * 1.0, 0.8 - 0.6 * 0.7408182206817179, 0.8 - 0.6 * 0.5488116360940264, 0.8 - 0.6 * 0.4065696597405991};
  for (int i = 0; i < 4; ++i) a.lam_init[i] = (float)li[i];
  void* kargs[] = {&a};
  hipError_t e = hipLaunchCooperativeKernel((void*)fwd_megakernel, dim3(grid), dim3(512), kargs, LDS_BYTES, stream);
  if (e != hipSuccess) fprintf(stderr, "kernel_launch: cooperative launch failed: %s (grid %d)\n", hipGetErrorString(e), grid);
}
```
